# Optimizing an MI355X kernel written in HIP

```python
import jax
import jax.numpy as jnp
from jax import lax
import numpy as np

D_MODEL = 1024
BATCH = 8
SEQ = 8192
DEPTH = 2

EPS = 1e-6
LRU_WIDTH = D_MODEL // 2
LRU_BLOCKS = 8
LRU_BLOCK = LRU_WIDTH // LRU_BLOCKS
LRU_CONV = 4
LRU_C = 8.0
HG_HEADS = 4
HG_DK = 128
HG_DV = 128
HG_WIDTH = HG_HEADS * HG_DV
HG_CHUNK = 64
EVEN_SPLITS = (LRU_WIDTH, 2 * LRU_WIDTH, 2 * LRU_WIDTH + HG_HEADS * HG_DK, 2 * LRU_WIDTH + 2 * HG_HEADS * HG_DK, 2 * LRU_WIDTH + 2 * HG_HEADS * HG_DK + HG_WIDTH)
EVEN_IN = 2 * LRU_WIDTH + 2 * HG_HEADS * HG_DK + 2 * HG_WIDTH
EVEN_OUT = LRU_WIDTH + HG_WIDTH
SGU_WIDTH = D_MODEL
SGU_GROUPS = 8
SGU_GROUP = SGU_WIDTH // SGU_GROUPS
SGU_CHUNK = 128
D_FF = 2816
FFN_CONV = 3
N_EVEN = (DEPTH + 1) // 2
N_ODD = DEPTH // 2

kernel_name = "hybrid_rglru_hgrn2_gmlp_convffn"


def rms_norm(x, g):
    xf = x.astype(jnp.float32)
    xf = xf * lax.rsqrt(jnp.mean(xf * xf, axis=-1, keepdims=True) + EPS)
    return (xf * g.astype(jnp.float32)).astype(x.dtype)


def layer_norm(x, g, b):
    xf = x.astype(jnp.float32)
    xc = xf - jnp.mean(xf, axis=-1, keepdims=True)
    var = jnp.mean(xc * xc, axis=-1, keepdims=True)
    return (xc * lax.rsqrt(var + EPS) * g.astype(jnp.float32) + b.astype(jnp.float32)).astype(x.dtype)


def causal_dwconv(x, w, b):
    k_w = w.shape[0]
    t = x.shape[1]
    xp = jnp.pad(x, ((0, 0), (k_w - 1, 0), (0, 0)))
    out = b
    for k in range(k_w):
        out = out + xp[:, k:k + t] * w[k]
    return out


def rg_lru(x, w_a, b_a, w_x, b_x, lam):
    bsz, t, _ = x.shape
    xf = x.astype(jnp.float32)
    xb = xf.reshape(bsz, t, LRU_BLOCKS, LRU_BLOCK)
    gate_r = jax.nn.sigmoid(jnp.einsum("btni,nij->btnj", xb, w_a.astype(jnp.float32)).reshape(bsz, t, LRU_WIDTH) + b_a.astype(jnp.float32))
    gate_i = jax.nn.sigmoid(jnp.einsum("btni,nij->btnj", xb, w_x.astype(jnp.float32)).reshape(bsz, t, LRU_WIDTH) + b_x.astype(jnp.float32))
    log_a = -LRU_C * gate_r * jax.nn.softplus(-lam.astype(jnp.float32))
    a = jnp.exp(log_a)
    u = jnp.sqrt(-jnp.expm1(2.0 * log_a)) * (gate_i * xf)

    def combine(left, right):
        a_l, h_l = left
        a_r, h_r = right
        return a_l * a_r, a_r * h_l + h_r

    _, h = lax.associative_scan(combine, (a, u), axis=1)
    return h


def hgrn2(q, f_logit, v, g, lb, g_norm):
    bsz, t = q.shape[:2]
    n_c = t // HG_CHUNK
    lbh = lb.astype(jnp.float32).reshape(HG_HEADS, HG_DK)
    f = lbh + (1.0 - lbh) * jax.nn.sigmoid(f_logit.astype(jnp.float32))
    shp_k = (bsz, n_c, HG_CHUNK, HG_HEADS, HG_DK)
    shp_v = (bsz, n_c, HG_CHUNK, HG_HEADS, HG_DV)
    k = (1.0 - f).reshape(shp_k)
    qf = jax.nn.silu(q.astype(jnp.float32)).reshape(shp_k)
    vf = v.astype(jnp.float32).reshape(shp_v)
    b_cum = jnp.cumsum(jnp.log(f).reshape(shp_k), axis=2)
    b_mid = b_cum[:, :, HG_CHUNK // 2 - 1:HG_CHUNK // 2]
    b_last = b_cum[:, :, HG_CHUNK - 1:]
    scores = jnp.einsum("bnthd,bnshd->bnhts", qf * jnp.exp(b_cum - b_mid), k * jnp.exp(b_mid - b_cum))
    causal = jnp.tril(jnp.ones((HG_CHUNK, HG_CHUNK), dtype=bool))
    scores = jnp.where(causal, scores, 0.0)
    o_intra = jnp.einsum("bnhts,bnshv->bnthv", scores, vf)
    q_in = qf * jnp.exp(b_cum)
    kv = jnp.einsum("bnshd,bnshv->bnhdv", k * jnp.exp(b_last - b_cum), vf)
    decay = jnp.exp(b_last[:, :, 0])

    def step(state, xs):
        d_n, kv_n, q_n = xs
        o_n = jnp.einsum("bthd,bhdv->bthv", q_n, state)
        return d_n[..., None] * state + kv_n, o_n

    s0 = jnp.zeros((bsz, HG_HEADS, HG_DK, HG_DV), jnp.float32)
    _, o_inter = lax.scan(step, s0, (jnp.moveaxis(decay, 1, 0), jnp.moveaxis(kv, 1, 0), jnp.moveaxis(q_in, 1, 0)))
    o = (o_intra + jnp.moveaxis(o_inter, 0, 1)).reshape(bsz, t, HG_HEADS, HG_DV)
    o = rms_norm(o, g_norm) * jax.nn.silu(g.astype(jnp.float32))
    return o.reshape(bsz, t, HG_WIDTH)


def even_mixer(h, w_in, conv_w, conv_b, ga_w, ga_b, gx_w, gx_b, lam, lb, hg_norm, w_out):
    bsz, t, _ = h.shape
    z = h @ w_in
    y_gate, x_rec, q, f_logit, v, g = jnp.split(z, list(EVEN_SPLITS), axis=-1)
    x_rec = causal_dwconv(x_rec, conv_w, conv_b)
    out_a = jax.nn.gelu(y_gate.astype(jnp.float32)) * rg_lru(x_rec, ga_w, ga_b, gx_w, gx_b, lam)
    out_b = hgrn2(q.reshape(bsz, t, HG_HEADS, HG_DK), f_logit.reshape(bsz, t, HG_HEADS, HG_DK), v.reshape(bsz, t, HG_HEADS, HG_DV), g.reshape(bsz, t, HG_HEADS, HG_DV), lb, hg_norm)
    return jnp.concatenate([out_a, out_b], axis=-1).astype(h.dtype) @ w_out


def odd_mixer(h, w_in, b_in, ln_g, ln_b, w_s, b_s, w_out):
    bsz, t, _ = h.shape
    n_c = t // SGU_CHUNK
    z = jax.nn.gelu(h @ w_in + b_in)
    u, v = jnp.split(z, 2, axis=-1)
    v = layer_norm(v, ln_g, ln_b).reshape(bsz, n_c, SGU_CHUNK, SGU_GROUPS, SGU_GROUP)
    w_causal = jnp.where(jnp.tril(jnp.ones((SGU_CHUNK, SGU_CHUNK), dtype=bool)), w_s, 0.0)
    sv = jnp.einsum("gts,bnsgc->bntgc", w_causal, v) + b_s.T[:, :, None]
    return (u * sv.reshape(bsz, t, SGU_WIDTH)) @ w_out


def conv_ffn(h, w_up, conv_w, conv_b, w_down):
    gate, up = jnp.split(h @ w_up, 2, axis=-1)
    gate = causal_dwconv(gate, conv_w, conv_b)
    return (jax.nn.silu(gate) * up) @ w_down


def setup_inputs(seed: int = 0) -> dict:
    key = jax.random.key(seed)
    ks = jax.random.split(key, 26)
    f32 = jnp.float32

    def nrm(k, shape, scale):
        return jax.random.normal(k, shape, f32) * scale

    def gain(k, shape):
        return 1.0 + 0.02 * jax.random.normal(k, shape, f32)

    a_c = jax.random.uniform(ks[11], (N_EVEN, LRU_WIDTH), f32, 0.9, 0.999)
    s = a_c ** (1.0 / LRU_C)
    lam = jnp.log(s) - jnp.log1p(-s)
    return {
        "x": nrm(ks[0], (BATCH, SEQ, D_MODEL), 1.0),
        "norm_mix": gain(ks[1], (DEPTH, D_MODEL)),
        "norm_ffn": gain(ks[2], (DEPTH, D_MODEL)),
        "norm_final": gain(ks[3], (D_MODEL,)),
        "ev_w_in": nrm(ks[4], (N_EVEN, D_MODEL, EVEN_IN), D_MODEL ** -0.5),
        "ev_conv_w": nrm(ks[5], (N_EVEN, LRU_CONV, LRU_WIDTH), LRU_CONV ** -0.5),
        "ev_conv_b": nrm(ks[6], (N_EVEN, LRU_WIDTH), 0.02),
        "ev_gate_a_w": nrm(ks[7], (N_EVEN, LRU_BLOCKS, LRU_BLOCK, LRU_BLOCK), LRU_BLOCK ** -0.5),
        "ev_gate_a_b": nrm(ks[8], (N_EVEN, LRU_WIDTH), 0.02),
        "ev_gate_x_w": nrm(ks[9], (N_EVEN, LRU_BLOCKS, LRU_BLOCK, LRU_BLOCK), LRU_BLOCK ** -0.5),
        "ev_gate_x_b": nrm(ks[10], (N_EVEN, LRU_WIDTH), 0.02),
        "ev_lru_lambda": lam,
        "hg_lb_logits": nrm(ks[12], (DEPTH + 1, HG_HEADS * HG_DK), 0.1),
        "ev_hg_norm": gain(ks[13], (N_EVEN, HG_DV)),
        "ev_w_out": nrm(ks[14], (N_EVEN, EVEN_OUT, D_MODEL), EVEN_OUT ** -0.5),
        "od_w_in": nrm(ks[15], (N_ODD, D_MODEL, 2 * SGU_WIDTH), D_MODEL ** -0.5),
        "od_b_in": nrm(ks[16], (N_ODD, 2 * SGU_WIDTH), 0.02),
        "od_ln_g": gain(ks[17], (N_ODD, SGU_WIDTH)),
        "od_ln_b": nrm(ks[18], (N_ODD, SGU_WIDTH), 0.02),
        "od_w_s": nrm(ks[19], (N_ODD, SGU_GROUPS, SGU_CHUNK, SGU_CHUNK), 0.5 * SGU_CHUNK ** -0.5),
        "od_b_s": gain(ks[20], (N_ODD, SGU_GROUPS, SGU_CHUNK)),
        "od_w_out": nrm(ks[21], (N_ODD, SGU_WIDTH, D_MODEL), SGU_WIDTH ** -0.5),
        "ffn_w_up": nrm(ks[22], (DEPTH, D_MODEL, 2 * D_FF), D_MODEL ** -0.5),
        "ffn_conv_w": nrm(ks[23], (DEPTH, FFN_CONV, D_FF), FFN_CONV ** -0.5),
        "ffn_conv_b": nrm(ks[24], (DEPTH, D_FF), 0.02),
        "ffn_w_down": nrm(ks[25], (DEPTH, D_FF, D_MODEL), D_FF ** -0.5),
    }


def reference(x, norm_mix, norm_ffn, norm_final, ev_w_in, ev_conv_w, ev_conv_b, ev_gate_a_w, ev_gate_a_b, ev_gate_x_w, ev_gate_x_b, ev_lru_lambda, hg_lb_logits, ev_hg_norm, ev_w_out, od_w_in, od_b_in, od_ln_g, od_ln_b, od_w_s, od_b_s, od_w_out, ffn_w_up, ffn_conv_w, ffn_conv_b, ffn_w_down):
    lower_bounds = jnp.cumsum(jax.nn.softmax(hg_lb_logits.astype(jnp.float32), axis=0), axis=0)
    h = x
    for layer in range(DEPTH):
        hn = rms_norm(h, norm_mix[layer])
        if layer % 2 == 0:
            e = layer // 2
            mix = even_mixer(hn, ev_w_in[e], ev_conv_w[e], ev_conv_b[e], ev_gate_a_w[e], ev_gate_a_b[e], ev_gate_x_w[e], ev_gate_x_b[e], ev_lru_lambda[e], lower_bounds[layer], ev_hg_norm[e], ev_w_out[e])
        else:
            o = layer // 2
            mix = odd_mixer(hn, od_w_in[o], od_b_in[o], od_ln_g[o], od_ln_b[o], od_w_s[o], od_b_s[o], od_w_out[o])
        h = h + mix.astype(h.dtype)
        h = h + conv_ffn(rms_norm(h, norm_ffn[layer]), ffn_w_up[layer], ffn_conv_w[layer], ffn_conv_b[layer], ffn_w_down[layer]).astype(h.dtype)
    return rms_norm(h, norm_final)
```

```cpp
#include <hip/hip_runtime.h>
#include <hip/hip_cooperative_groups.h>
#include <cstdio>
namespace cg = cooperative_groups;

#ifndef ONE_LAUNCH
#define ONE_LAUNCH 1
#endif

#define LAS __attribute__((address_space(3)))
#define DI __device__ __forceinline__
typedef unsigned short bf16_t;
typedef short bf16x8 __attribute__((ext_vector_type(8)));
typedef float f32x4 __attribute__((ext_vector_type(4)));
typedef float f32x2 __attribute__((ext_vector_type(2)));
typedef unsigned u32x4 __attribute__((ext_vector_type(4)));
typedef unsigned u32x2 __attribute__((ext_vector_type(2)));

constexpr int MTOK = 65536, DM = 1024, TSEQ = 8192, NBATCH = 8, DFF = 2816;
constexpr int LDS_BYTES = 131072 + 4096 + 23552 + 16;
constexpr int NTHR = 512;

constexpr size_t MiB = 1024ull * 1024ull;
constexpr size_t WS_WIN0 = 1 * MiB;
constexpr size_t WS_WOUT0 = WS_WIN0 + 6 * MiB;
constexpr size_t WS_WUP0 = WS_WOUT0 + 2 * MiB;
constexpr size_t WS_WDN0 = WS_WUP0 + 11 * MiB;
constexpr size_t WS_WIN1 = WS_WDN0 + 11 * MiB / 2;
constexpr size_t WS_WOUT1 = WS_WIN1 + 4 * MiB;
constexpr size_t WS_WUP1 = WS_WOUT1 + 2 * MiB;
constexpr size_t WS_WDN1 = WS_WUP1 + 11 * MiB;
constexpr size_t WS_WSC = 48 * MiB;
constexpr size_t WS_SSQ = 49 * MiB;
constexpr size_t WS_VST = 53 * MiB;
constexpr size_t WS_LRUAGG = 61 * MiB;
constexpr size_t WS_HGD = 62 * MiB;
constexpr size_t WS_HGS = 63 * MiB;
constexpr size_t WS_HB = 80 * MiB;
constexpr size_t WS_R1 = 208 * MiB;
constexpr size_t WS_Z = WS_R1;
constexpr size_t WS_MIX = WS_R1 + 384 * MiB;
constexpr size_t WS_ACT = WS_R1;
constexpr size_t WS_UV = WS_R1;
constexpr size_t WS_SG = WS_R1 + 384 * MiB;
constexpr size_t WS_END = WS_R1 + 528 * MiB;

struct Args { const float* in[26]; float* out; unsigned char* ws; int ph_lo, ph_hi; int seq[32]; };

typedef __bf16 bf16x2_t __attribute__((ext_vector_type(2)));
DI unsigned cvt_pk_bf16(float lo, float hi) { const bf16x2_t v = __builtin_convertvector((f32x2){lo, hi}, bf16x2_t); return __builtin_bit_cast(unsigned, v); }
DI bf16_t f2bf(float f) { return (bf16_t)(cvt_pk_bf16(f, 0.f) & 0xffffu); }
DI float bf2f(bf16_t b) { return __builtin_bit_cast(float, (unsigned)b << 16); }
DI float bflo(unsigned w) { return __builtin_bit_cast(float, w << 16); }
DI float bfhi(unsigned w) { return __builtin_bit_cast(float, w & 0xffff0000u); }
DI int tid_() { int t = (int)threadIdx.x; asm volatile("" : "+v"(t)); return t; }
DI int bid_() { int b = __builtin_amdgcn_workgroup_id_x(); asm volatile("" : "+s"(b)); return b; }
DI float sigmoidf_(float x) { return __builtin_amdgcn_rcpf(1.0f + __builtin_amdgcn_exp2f(x * -1.44269504f)); }
DI float siluf_(float x) { return x * sigmoidf_(x); }
DI float geluf_(float x) { const float y = 1.5957691216f * (x + 0.044715f * x * x * x); return x * sigmoidf_(y); }
DI float wave_sum(float v) {
#pragma unroll
    for (int o = 1; o < 64; o <<= 1) v += __shfl_xor(v, o);
    return v;
}
DI f32x4 mma16(const LAS bf16_t* A, int lda, const LAS bf16_t* Bt, int ldb, int K, f32x4 acc, int lane) {
    const LAS bf16_t* a = A + (lane & 15) * lda + 8 * (lane >> 4);
    const LAS bf16_t* b = Bt + (lane & 15) * ldb + 8 * (lane >> 4);
#pragma unroll
    for (int k = 0; k < K; k += 32) {
        const bf16x8 av = *(const LAS bf16x8*)(a + k); const bf16x8 bv = *(const LAS bf16x8*)(b + k);
        acc = __builtin_amdgcn_mfma_f32_16x16x32_bf16(av, bv, acc, 0, 0, 0);
    }
    return acc;
}

namespace pg8 {
constexpr int BM = 256, BK = 64, HALF = 128, HTB = HALF * BK * 2, STAGE_BYTES = 8 * HTB, NXCD = 8, WGM = 8;
DI int lds_byte(int r, int c) { const int st = (r >> 4) * 2 + (c >> 5), rr = r & 15, cc = c & 31, ob = rr * 64 + cc * 2; return st * 1024 + (ob ^ (((ob >> 9) & 1) << 5)); }
DI void stage_rc(int b, int& R, int& C) { const int st = b / 1024, sb = b % 1024, swz = sb ^ (((sb >> 9) & 1) << 5); R = (st >> 1) * 16 + swz / 64; C = (st & 1) * 32 + (swz % 64) / 2; }
DI int perm32(int rho) { const int n = rho >> 4, i = rho & 15; return 8 * (i >> 2) + 4 * n + (i & 3); }
struct Unit { int pm, pn, arow, ord; };
struct Gemm { const bf16_t* A; const bf16_t* Bt; int M, N, K; };
struct StaticOrder {
    int nM, nN, nwg, G, c, ffn;
    DI void init(int M, int N, int G_, int c_) { nM = M / BM; nN = N / BM; nwg = nM * nN; G = G_; c = c_; ffn = 0; }
    DI void init_ffn(int G_, int c_) { nM = 264; nN = 22; nwg = nM * nN; G = G_; c = c_; ffn = 1; }
    DI bool next(int i, Unit& u) const {
        const long L = (long)i * G + c; if (L >= nwg) return false;
        int wgid = (int)L; { const int q = nwg / NXCD, r = nwg % NXCD, xcd = wgid % NXCD, off = wgid / NXCD; wgid = (xcd < r ? xcd * (q + 1) : r * (q + 1) + (xcd - r) * q) + off; }
        const int nig = WGM * nN, gid = wgid / nig, fm = gid * WGM, gsz = (nM - fm) < WGM ? (nM - fm) : WGM;
        u.pm = fm + ((wgid % nig) % gsz); u.pn = (wgid % nig) / gsz;
        if (ffn) { const int bb = u.pm / 33, ii = u.pm - bb * 33; u.arow = bb * 8192 + ii * 254 - 2; } else u.arow = u.pm * BM;
        return true;
    }
};

template <class Epi>
DI void gemm_phase(LAS unsigned char* lds, const Gemm g, const StaticOrder& S, const Epi& E) {
    const int tid = tid_(), wid = __builtin_amdgcn_readfirstlane(tid >> 6), lane = tid & 63, wr = wid >> 2, wc = wid & 3, fr = lane & 15, fq = lane >> 4;
    const int K = g.K, nt = K / BK;
    unsigned voffA[2], voffB[2];
#pragma unroll
    for (int i = 0; i < 2; ++i) { int R, C; stage_rc(tid * 16 + i * 8192, R, C); const int Rb = Epi::PERM ? ((R & ~31) + perm32(R & 31)) : R;
        voffA[i] = (unsigned)(R * K + C) * 2u; voffB[i] = (unsigned)(Rb * K + C) * 2u; }
    const size_t kstep = (size_t)(BK * 2);
    const size_t hstep = (size_t)HALF * K * 2;
    const size_t tstep = 2 * hstep;
    const unsigned ldsw = (unsigned)wid * 1024u;
    const int aoff = lds_byte(wr * 64 + fr, fq * 8), boff = lds_byte(wc * 32 + fr, fq * 8);
#define PG8_SA(b, h) (((b) * 2 + (h)) * HTB)
#define PG8_SB(b, h) ((4 + (b) * 2 + (h)) * HTB)
#define PG8_STAGE(bufoff, gbase, voff) do { _Pragma("unroll") for (int _i = 0; _i < 2; ++_i) \
        __builtin_amdgcn_global_load_lds((const unsigned*)((const char*)(gbase) + (voff)[_i]), (LAS unsigned*)(lds + (bufoff) + ldsw + _i * 8192), 16, 0, 0); } while (0)
#define PG8_LDA(dst, b, h) do { _Pragma("unroll") for (int m = 0; m < 4; ++m) _Pragma("unroll") for (int k = 0; k < 2; ++k) dst[m][k] = *(const LAS bf16x8*)(lds + PG8_SA(b, h) + aoff + m * 2048 + k * 1024); } while (0)
#define PG8_LDB(dst, b, h) do { _Pragma("unroll") for (int n = 0; n < 2; ++n) _Pragma("unroll") for (int k = 0; k < 2; ++k) dst[n][k] = *(const LAS bf16x8*)(lds + PG8_SB(b, h) + boff + n * 2048 + k * 1024); } while (0)
#define PG8_MMA(ai, bj, At, Bt) do { __builtin_amdgcn_s_setprio(1); _Pragma("unroll") for (int m = 0; m < 4; ++m) _Pragma("unroll") for (int n = 0; n < 2; ++n) _Pragma("unroll") for (int k = 0; k < 2; ++k) \
        acc[ai][bj][m][n] = __builtin_amdgcn_mfma_f32_16x16x32_bf16(Bt[n][k], At[m][k], acc[ai][bj][m][n], 0, 0, 0); __builtin_amdgcn_s_setprio(0); } while (0)
#define PG8_WAIT_V(n) asm volatile("s_waitcnt vmcnt(" #n ")" ::: "memory")
#define PG8_WAIT_L(n) asm volatile("s_waitcnt lgkmcnt(" #n ")" ::: "memory")
#define PG8_BAR __builtin_amdgcn_s_barrier()
#define PG8_SCHED __builtin_amdgcn_sched_barrier(0)
    Unit cur, nxt; nxt.pm = 0; nxt.pn = 0; nxt.arow = 0; nxt.ord = 0; int ui = 0;
    if (!S.next(0, cur)) return;
    cur.ord = 0;
    f32x4 acc[2][2][4][2];
#pragma unroll
    for (int a = 0; a < 2; ++a)
#pragma unroll
        for (int b = 0; b < 2; ++b)
#pragma unroll
            for (int m = 0; m < 4; ++m)
#pragma unroll
                for (int n = 0; n < 2; ++n) acc[a][b][m][n] = (f32x4){0.f, 0.f, 0.f, 0.f};
    bf16x8 At[4][2], B0[2][2], B1[2][2];
    const char* cA = (const char*)g.A + (ptrdiff_t)cur.arow * (ptrdiff_t)(K * 2); const char* cB = (const char*)g.Bt + (size_t)cur.pn * tstep;
    PG8_STAGE(PG8_SB(0, 0), cB, voffB); PG8_STAGE(PG8_SA(0, 0), cA, voffA); PG8_STAGE(PG8_SB(0, 1), cB + hstep, voffB); PG8_STAGE(PG8_SA(0, 1), cA + hstep, voffA);
    if (wr == 1) PG8_BAR;
    PG8_WAIT_V(4); PG8_BAR;
    PG8_STAGE(PG8_SB(1, 0), cB + kstep, voffB); PG8_STAGE(PG8_SA(1, 0), cA + kstep, voffA); PG8_STAGE(PG8_SB(1, 1), cB + hstep + kstep, voffB);
    PG8_WAIT_V(6); PG8_BAR;
    for (;;) {
        const bool has_next = S.next(ui + 1, nxt); nxt.ord = ui + 1;
        const char* nA = has_next ? (const char*)g.A + (ptrdiff_t)nxt.arow * (ptrdiff_t)(K * 2) : cA; const char* nB = has_next ? (const char*)g.Bt + (size_t)nxt.pn * tstep : cB;
        for (int t = 0; t < nt; t += 2) {
            const bool last = (t == nt - 2);
            const char* a1 = cA + (size_t)(t + 1) * kstep;
            const char* a2 = last ? nA : cA + (size_t)(t + 2) * kstep; const char* b2 = last ? nB : cB + (size_t)(t + 2) * kstep;
            const char* a3 = a2 + kstep; const char* b3 = b2 + kstep;
            PG8_LDB(B0, 0, 0); PG8_SCHED; PG8_LDA(At, 0, 0); PG8_STAGE(PG8_SA(1, 1), a1 + hstep, voffA);
            PG8_WAIT_L(8); PG8_BAR; PG8_WAIT_L(0); PG8_MMA(0, 0, At, B0); PG8_BAR; PG8_SCHED;
            PG8_LDB(B1, 0, 1); PG8_STAGE(PG8_SB(0, 0), b2, voffB);
            PG8_BAR; PG8_WAIT_L(0); PG8_MMA(0, 1, At, B1); PG8_BAR;
            PG8_LDA(At, 0, 1); PG8_STAGE(PG8_SA(0, 0), a2, voffA);
            PG8_BAR; PG8_WAIT_L(0); PG8_MMA(1, 0, At, B0); PG8_BAR; PG8_SCHED;
            PG8_STAGE(PG8_SB(0, 1), b2 + hstep, voffB);
            PG8_WAIT_V(6); PG8_BAR; PG8_MMA(1, 1, At, B1); PG8_BAR;
            PG8_LDB(B0, 1, 0); PG8_SCHED; PG8_LDA(At, 1, 0); PG8_STAGE(PG8_SA(0, 1), a2 + hstep, voffA);
            PG8_WAIT_L(8); PG8_BAR; PG8_WAIT_L(0); PG8_MMA(0, 0, At, B0); PG8_BAR; PG8_SCHED;
            PG8_LDB(B1, 1, 1); PG8_STAGE(PG8_SB(1, 0), b3, voffB);
            PG8_BAR; PG8_WAIT_L(0); PG8_MMA(0, 1, At, B1); PG8_BAR;
            PG8_LDA(At, 1, 1); PG8_STAGE(PG8_SA(1, 0), a3, voffA);
            PG8_BAR; PG8_WAIT_L(0); PG8_MMA(1, 0, At, B0); PG8_BAR; PG8_SCHED;
            PG8_STAGE(PG8_SB(1, 1), b3 + hstep, voffB);
            PG8_WAIT_V(6); PG8_BAR; PG8_MMA(1, 1, At, B1); PG8_BAR;
        }
        E(acc, cur, wr, wc, fr, fq);
        if (!has_next) break;
#pragma unroll
        for (int a = 0; a < 2; ++a)
#pragma unroll
            for (int b = 0; b < 2; ++b)
#pragma unroll
                for (int m = 0; m < 4; ++m)
#pragma unroll
                    for (int n = 0; n < 2; ++n) acc[a][b][m][n] = (f32x4){0.f, 0.f, 0.f, 0.f};
        cur = nxt; cA = nA; cB = nB; ++ui;
    }
    PG8_WAIT_V(0);
    if (wr == 0) PG8_BAR;
    PG8_BAR;
#undef PG8_SA
#undef PG8_SB
#undef PG8_STAGE
#undef PG8_LDA
#undef PG8_LDB
#undef PG8_MMA
#undef PG8_WAIT_V
#undef PG8_WAIT_L
#undef PG8_BAR
#undef PG8_SCHED
}
}

DI float ssq_rs(const float* ssq, size_t row) {
    const f32x4* q = (const f32x4*)(ssq + row * 16);
    const f32x4 a = q[0], b = q[1], c = q[2], d = q[3];
    const float s = (((a[0] + a[1]) + (a[2] + a[3])) + ((b[0] + b[1]) + (b[2] + b[3]))) + (((c[0] + c[1]) + (c[2] + c[3])) + ((d[0] + d[1]) + (d[2] + d[3])));
    return rsqrtf(s * (1.0f / 1024.0f) + 1e-6f);
}

constexpr int RST_OFF = 131072 + 4096, RST_MAXU = 23;
DI void build_rstab(LAS unsigned char* lds, const pg8::StaticOrder& S, const float* ssq, int row_max) {
    LAS float* RST = (LAS float*)(lds + RST_OFF);
    const int tid = tid_(), r = tid & 255, par = tid >> 8;
    for (int i = par; i < RST_MAXU; i += 2) { pg8::Unit u; if (!S.next(i, u)) break;
        int grow = u.arow + r; grow = grow < 0 ? 0 : (grow > row_max ? row_max : grow);
        RST[i * 256 + r] = ssq_rs(ssq, (size_t)grow); }
    __syncthreads();
}
struct EpiScale {
    static constexpr bool PERM = true;
    bf16_t* O; int ldc; const LAS float* RST;
    DI void operator()(const f32x4 (&acc)[2][2][4][2], const pg8::Unit& u, int wr, int wc, int fr, int fq) const {
        const int row0 = u.pm * 256 + wr * 64 + fr, col0 = u.pn * 256 + wc * 32 + 8 * fq;
        const int tsel = u.pn >> 1; const int actsel = (tsel == 0) ? 1 : ((tsel == 2 || tsel == 5) ? 2 : 0);
#pragma unroll
        for (int ai = 0; ai < 2; ++ai)
#pragma unroll
            for (int m = 0; m < 4; ++m) {
                const size_t row = (size_t)(row0 + ai * 128 + m * 16); const float rs = RST[u.ord * 256 + wr * 64 + fr + ai * 128 + m * 16];
                bf16_t* rowp = O + row * ldc + col0;
#pragma unroll
                for (int bj = 0; bj < 2; ++bj) { f32x4 v0 = acc[ai][bj][m][0] * rs, v1 = acc[ai][bj][m][1] * rs;
                    if (actsel == 1) {
#pragma unroll
                        for (int j = 0; j < 4; ++j) { v0[j] = geluf_(v0[j]); v1[j] = geluf_(v1[j]); } }
                    else if (actsel == 2) {
#pragma unroll
                        for (int j = 0; j < 4; ++j) { v0[j] = siluf_(v0[j]); v1[j] = siluf_(v1[j]); } }
                    u32x4 w; w.x = cvt_pk_bf16(v0[0], v0[1]); w.y = cvt_pk_bf16(v0[2], v0[3]); w.z = cvt_pk_bf16(v1[0], v1[1]); w.w = cvt_pk_bf16(v1[2], v1[3]);
                    *(u32x4*)(rowp + bj * 128) = w; }
            }
    }
};
struct EpiGelu {
    static constexpr bool PERM = true;
    bf16_t* O; int ldc; const LAS float* RST; const float* bias; float* vst;
    DI void operator()(const f32x4 (&acc)[2][2][4][2], const pg8::Unit& u, int wr, int wc, int fr, int fq) const {
        const int row0 = u.pm * 256 + wr * 64 + fr, col0 = u.pn * 256 + wc * 32 + 8 * fq;
        f32x4 bv[2][2];
#pragma unroll
        for (int bj = 0; bj < 2; ++bj)
#pragma unroll
            for (int n = 0; n < 2; ++n) bv[bj][n] = *(const f32x4*)(bias + col0 + bj * 128 + 4 * n);
#pragma unroll
        for (int ai = 0; ai < 2; ++ai)
#pragma unroll
            for (int m = 0; m < 4; ++m) {
                const size_t row = (size_t)(row0 + ai * 128 + m * 16); const float rs = RST[u.ord * 256 + wr * 64 + fr + ai * 128 + m * 16];
                bf16_t* rowp = O + row * ldc + col0; float s1 = 0.f, s2 = 0.f;
#pragma unroll
                for (int bj = 0; bj < 2; ++bj) { f32x4 v0 = acc[ai][bj][m][0] * rs + bv[bj][0], v1 = acc[ai][bj][m][1] * rs + bv[bj][1];
#pragma unroll
                    for (int j = 0; j < 4; ++j) { v0[j] = geluf_(v0[j]); v1[j] = geluf_(v1[j]); s1 += v0[j] + v1[j]; s2 += v0[j] * v0[j] + v1[j] * v1[j]; }
                    u32x4 w; w.x = cvt_pk_bf16(v0[0], v0[1]); w.y = cvt_pk_bf16(v0[2], v0[3]); w.z = cvt_pk_bf16(v1[0], v1[1]); w.w = cvt_pk_bf16(v1[2], v1[3]);
                    *(u32x4*)(rowp + bj * 128) = w; }
                if (u.pn >= 4) {
                    s1 += __shfl_xor(s1, 16); s1 += __shfl_xor(s1, 32); s2 += __shfl_xor(s2, 16); s2 += __shfl_xor(s2, 32);
                    if (fq == 0) *(f32x2*)(vst + (row * 16 + (size_t)((u.pn - 4) * 4 + wc)) * 2) = (f32x2){s1, s2};
                }
            }
    }
};
struct EpiRes {
    static constexpr bool PERM = false;
    bf16_t* hb; float* ssq;
    DI void operator()(const f32x4 (&acc)[2][2][4][2], const pg8::Unit& u, int wr, int wc, int fr, int fq) const {
        const int row0 = u.pm * 256 + wr * 64 + fr, col0 = u.pn * 256 + wc * 32 + 4 * fq;
#pragma unroll
        for (int ai = 0; ai < 2; ++ai) {
            u32x2 rr[4][2][2];
#pragma unroll
            for (int m = 0; m < 4; ++m) { const size_t off = (size_t)(row0 + ai * 128 + m * 16) * DM + col0;
#pragma unroll
                for (int bj = 0; bj < 2; ++bj)
#pragma unroll
                    for (int n = 0; n < 2; ++n) rr[m][bj][n] = *(const u32x2*)(hb + off + bj * 128 + n * 16); }
#pragma unroll
            for (int m = 0; m < 4; ++m) { const size_t row = (size_t)(row0 + ai * 128 + m * 16); const size_t off = row * DM + col0; float sq = 0.f;
#pragma unroll
                for (int bj = 0; bj < 2; ++bj)
#pragma unroll
                    for (int n = 0; n < 2; ++n) {
                        const u32x2 r = rr[m][bj][n]; const f32x4 v = acc[ai][bj][m][n] + (f32x4){bflo(r.x), bfhi(r.x), bflo(r.y), bfhi(r.y)};
                        u32x2 w; w.x = cvt_pk_bf16(v[0], v[1]); w.y = cvt_pk_bf16(v[2], v[3]); *(u32x2*)(hb + off + bj * 128 + n * 16) = w;
                        sq += (v[0] * v[0] + v[1] * v[1]) + (v[2] * v[2] + v[3] * v[3]);
                    }
                sq += __shfl_xor(sq, 16); sq += __shfl_xor(sq, 32);
                if (fq == 0) ssq[row * 16 + (size_t)(u.pn * 4 + wc)] = sq; }
        }
    }
};

template <int CTRL> DI float dppmov(float oldv, float src) { return __builtin_bit_cast(float, __builtin_amdgcn_update_dpp(__builtin_bit_cast(int, oldv), __builtin_bit_cast(int, src), CTRL, 0xf, 0xf, false)); }
struct EpiFfn {
    static constexpr bool PERM = true;
    bf16_t* act; const LAS float* RST; const float* cw; const float* cb; LAS float* X;
    DI void operator()(f32x4 (&acc)[2][2][4][2], const pg8::Unit& u, int wr, int wc, int fr_, int fq_) const {
        int fr = fr_, fq = fq_; asm volatile("" : "+v"(fr), "+v"(fq));
        const int bb = u.pm / 33, ii = u.pm - bb * 33; const int tok0 = ii * 254 - 2;
        const int chl = wc * 32 + 8 * fq, ch = u.pn * 128 + chl;
#pragma unroll
        for (int ai = 0; ai < 2; ++ai)
#pragma unroll
            for (int m = 0; m < 4; ++m) {
                const int r = 128 * ai + 64 * wr + 16 * m + fr, tok = tok0 + r;
                const float rs = RST[u.ord * 256 + r];
#pragma unroll
                for (int n = 0; n < 2; ++n) { acc[ai][0][m][n] = (tok >= 0) ? acc[ai][0][m][n] * rs : (f32x4){0.f, 0.f, 0.f, 0.f}; acc[ai][1][m][n] = acc[ai][1][m][n] * rs; }
            }
#pragma unroll
        for (int ai = 0; ai < 2; ++ai) { const int slot = ai * 2 + wr;
            if (fr >= 14) {
#pragma unroll
                for (int n = 0; n < 2; ++n) *(LAS f32x4*)(X + ((slot * 2 + (fr - 14)) * 128 + chl + 4 * n)) = acc[ai][0][3][n]; } }
        asm volatile("s_waitcnt lgkmcnt(0)" ::: "memory"); __builtin_amdgcn_s_barrier(); asm volatile("" ::: "memory"); __builtin_amdgcn_s_barrier(); asm volatile("" ::: "memory");
        f32x4 w0[2], w1[2], w2[2], bv[2];
#pragma unroll
        for (int n = 0; n < 2; ++n) { w0[n] = *(const f32x4*)(cw + ch + 4 * n); w1[n] = *(const f32x4*)(cw + DFF + ch + 4 * n); w2[n] = *(const f32x4*)(cw + 2 * DFF + ch + 4 * n); bv[n] = *(const f32x4*)(cb + ch + 4 * n); }
#pragma unroll
        for (int ai = 0; ai < 2; ++ai) {
            const int slot = ai * 2 + wr; f32x4 prev[2];
            { const int rowsel = (fr == 15) ? 1 : 0; const int sl = slot > 0 ? slot - 1 : 0;
#pragma unroll
              for (int n = 0; n < 2; ++n) { prev[n] = *(const LAS f32x4*)(X + ((sl * 2 + rowsel) * 128 + chl + 4 * n)); if (slot == 0) prev[n] = (f32x4){0.f, 0.f, 0.f, 0.f}; } }
#pragma unroll
            for (int m = 0; m < 4; ++m) {
                const int r = 128 * ai + 64 * wr + 16 * m + fr, tok = tok0 + r; float o[8];
#pragma unroll
                for (int n = 0; n < 2; ++n)
#pragma unroll
                    for (int j = 0; j < 4; ++j) { const float g0 = acc[ai][0][m][n][j], p = prev[n][j];
                        const float rot1 = dppmov<0x121>(p, p), rot2 = dppmov<0x122>(p, p);
                        const float g1 = dppmov<0x111>(rot1, g0), g2 = dppmov<0x112>(rot2, g0);
                        const float cv = bv[n][j] + w0[n][j] * g2 + w1[n][j] * g1 + w2[n][j] * g0;
                        o[n * 4 + j] = siluf_(cv) * acc[ai][1][m][n][j]; }
                u32x4 ow; ow.x = cvt_pk_bf16(o[0], o[1]); ow.y = cvt_pk_bf16(o[2], o[3]); ow.z = cvt_pk_bf16(o[4], o[5]); ow.w = cvt_pk_bf16(o[6], o[7]);
                if (r >= 2 && tok < TSEQ) *(u32x4*)(act + (size_t)(bb * 8192 + tok) * DFF + ch) = ow;
                prev[0] = acc[ai][0][m][0]; prev[1] = acc[ai][0][m][1];
            }
        }
    }
};

template <class Epi> DI void run_gemm_ffn(LAS unsigned char* lds, int vc, const bf16_t* A, const bf16_t* Bt, const float* ssq, const Epi& E) {
    pg8::Gemm g{A, Bt, MTOK, 5632, 1024}; pg8::StaticOrder S; S.init_ffn((int)gridDim.x, vc);
    build_rstab(lds, S, ssq, MTOK - 1);
    pg8::gemm_phase<Epi>(lds, g, S, E);
}
template <class Epi> DI void run_gemm(LAS unsigned char* lds, int vc, const bf16_t* A, const bf16_t* Bt, int Mrows, int N, int K, const Epi& E, const float* ssq = nullptr) {
    pg8::Gemm g{A, Bt, Mrows, N, K}; pg8::StaticOrder S; S.init(Mrows, N, (int)gridDim.x, vc);
    if (ssq) build_rstab(lds, S, ssq, Mrows - 1);
    pg8::gemm_phase<Epi>(lds, g, S, E);
}

DI void transpose_item(const float* W, int K, int N, bf16_t* WT, const float* gain, LAS float* scr, int item, int lane, bool ffn_remap = false) {
    const int nblk = N / 32, kb = item / nblk, nb = item % nblk, k0 = 64 * kb, n0 = 32 * nb;
    const int r0 = ffn_remap ? ((n0 < DFF) ? (n0 / 128) * 256 + (n0 % 128) : ((n0 - DFF) / 128) * 256 + 128 + ((n0 - DFF) % 128)) : n0;
#pragma unroll 8
    for (int i = 0; i < 32; ++i) { const int kk = 2 * i + (lane >> 5); float v = W[(size_t)(k0 + kk) * N + n0 + (lane & 31)]; if (gain) v *= gain[k0 + kk]; scr[kk * 33 + (lane & 31)] = v; }
    asm volatile("s_waitcnt lgkmcnt(0)" ::: "memory");
    const int c = lane & 7;
#pragma unroll
    for (int j = 0; j < 4; ++j) { const int n = (lane >> 3) + 8 * j; const LAS float* s = scr + (8 * c) * 33 + n;
        u32x4 o; o.x = cvt_pk_bf16(s[0 * 33], s[1 * 33]); o.y = cvt_pk_bf16(s[2 * 33], s[3 * 33]); o.z = cvt_pk_bf16(s[4 * 33], s[5 * 33]); o.w = cvt_pk_bf16(s[6 * 33], s[7 * 33]);
        *(u32x4*)(WT + (size_t)(r0 + n) * K + k0 + 8 * c) = o; }
    asm volatile("s_waitcnt lgkmcnt(0)" ::: "memory");
}
DI void phase_prep(LAS unsigned char* lds, const Args& a) {
    const int tid = tid_(), lane = tid & 63, wave = tid >> 6;
    const int gw = bid_() * 8 + wave, NGW = (int)gridDim.x * 8;
    unsigned char* ws = a.ws;
    LAS float* scr = (LAS float*)(lds + wave * 8448);
    constexpr int I_IN0 = 16 * 96, I_OUT = 16 * 32, I_UP = 16 * 176, I_DN = 44 * 32, I_IN1 = 16 * 64;
    constexpr int NITEMS = I_IN0 + I_OUT + I_UP + I_DN + I_IN1 + I_OUT + I_UP + I_DN;
    for (int it = gw; it < NITEMS; it += NGW) {
        int r = it;
        if (r < I_IN0) { transpose_item(a.in[4], 1024, 3072, (bf16_t*)(ws + WS_WIN0), a.in[1], scr, r, lane); continue; } r -= I_IN0;
        if (r < I_OUT) { transpose_item(a.in[14], 1024, 1024, (bf16_t*)(ws + WS_WOUT0), nullptr, scr, r, lane); continue; } r -= I_OUT;
        if (r < I_UP) { transpose_item(a.in[22], 1024, 5632, (bf16_t*)(ws + WS_WUP0), a.in[2], scr, r, lane, true); continue; } r -= I_UP;
        if (r < I_DN) { transpose_item(a.in[25], 2816, 1024, (bf16_t*)(ws + WS_WDN0), nullptr, scr, r, lane); continue; } r -= I_DN;
        if (r < I_IN1) { transpose_item(a.in[15], 1024, 2048, (bf16_t*)(ws + WS_WIN1), a.in[1] + 1024, scr, r, lane); continue; } r -= I_IN1;
        if (r < I_OUT) { transpose_item(a.in[21], 1024, 1024, (bf16_t*)(ws + WS_WOUT1), nullptr, scr, r, lane); continue; } r -= I_OUT;
        if (r < I_UP) { transpose_item(a.in[22] + (size_t)1024 * 5632, 1024, 5632, (bf16_t*)(ws + WS_WUP1), a.in[2] + 1024, scr, r, lane, true); continue; } r -= I_UP;
        transpose_item(a.in[25] + (size_t)2816 * 1024, 2816, 1024, (bf16_t*)(ws + WS_WDN1), nullptr, scr, r, lane);
    }
    { const float* w_s = a.in[19]; bf16_t* wsc = (bf16_t*)(ws + WS_WSC);
      for (int i = bid_() * NTHR + tid; i < 8 * 128 * 128; i += (int)gridDim.x * NTHR) { const int t = (i >> 7) & 127, s = i & 127; wsc[i] = (s <= t) ? f2bf(w_s[i]) : (bf16_t)0; } }
    { const float* x = a.in[0]; bf16_t* xb = (bf16_t*)(ws + WS_HB); float* ssq = (float*)(ws + WS_SSQ);
      for (int m = gw; m < MTOK; m += NGW) {
          const f32x4* xr = (const f32x4*)(x + (size_t)m * DM) + lane; f32x4 v[4]; float s = 0.f;
#pragma unroll
          for (int j = 0; j < 4; ++j) { v[j] = xr[64 * j]; s += (v[j][0] * v[j][0] + v[j][1] * v[j][1]) + (v[j][2] * v[j][2] + v[j][3] * v[j][3]); }
          s = wave_sum(s);
          u32x2* o8 = (u32x2*)(xb + (size_t)m * DM) + lane;
#pragma unroll
          for (int j = 0; j < 4; ++j) { u32x2 w; w.x = cvt_pk_bf16(v[j][0], v[j][1]); w.y = cvt_pk_bf16(v[j][2], v[j][3]); o8[64 * j] = w; }
          if (lane < 16) ssq[(size_t)m * 16 + lane] = (lane == 0) ? s : 0.f;
      } }
}

template <bool FINAL>
DI void lru_item(LAS unsigned char* lds, const Args& a, int it) {
    const int tid = tid_(), lane = tid & 63, w = tid >> 6;
    const int b = it >> 5, cb = (it >> 2) & 7, seg = it & 3;
    const bf16_t* z = (const bf16_t*)(a.ws + WS_Z); bf16_t* mix = (bf16_t*)(a.ws + WS_MIX); float* agg = (float*)(a.ws + WS_LRUAGG);
    LAS bf16_t* WaT = (LAS bf16_t*)lds;
    LAS bf16_t* WxT = WaT + 64 * 72;
    LAS bf16_t* XR = WxT + 64 * 72;
    LAS bf16_t* XC = XR + 132 * 64;
    LAS float* AA = (LAS float*)(XC + 128 * 72);
    LAS float* UU = AA + 128 * 64;
    LAS float* SPp = UU + 128 * 64;
    LAS float* SHh = SPp + 512;
    LAS float* TAB = SHh + 512;
    LAS bf16_t* YT = (LAS bf16_t*)(TAB + 512);
    static_assert((64 * 72 * 2 + 132 * 64 + 128 * 72) * 2 + (128 * 64 * 2 + 512 * 3) * 4 + 128 * 64 * 2 <= 158720, "lru lds");
    { const float* wa = a.in[7] + cb * 4096; const float* wx = a.in[9] + cb * 4096;
#pragma unroll
      for (int r = 0; r < 8; ++r) { const int e = tid + 512 * r, i = e >> 6, j = e & 63; WaT[j * 72 + i] = f2bf(wa[e]); WxT[j * 72 + i] = f2bf(wx[e]); }
      if (tid < 64) { const int ch = cb * 64 + tid;
#pragma unroll
          for (int k = 0; k < 4; ++k) TAB[k * 64 + tid] = a.in[5][k * 512 + ch];
          TAB[256 + tid] = a.in[6][ch]; TAB[320 + tid] = a.in[8][ch]; TAB[384 + tid] = a.in[10][ch]; TAB[448 + tid] = log1pf(expf(-a.in[11][ch])); } }
    const int c = tid & 63, sub = tid >> 6;
    float h = 0.f, Ptot = 1.f;
    if (FINAL) for (int j = 0; j < seg; ++j) { const f32x2 pq = *(const f32x2*)(agg + ((size_t)((b * 4 + j) * 512 + cb * 64 + c)) * 2); h = pq[0] * h + pq[1]; }
    const bf16_t* zb = z + (size_t)b * TSEQ * 3072 + cb * 64 + (tid & 7) * 8;
    const int prow = tid >> 3;
    u32x4 pfx[3], pfy[2];
    { const int t0 = seg * 2048;
#pragma unroll
      for (int k = 0; k < 3; ++k) { const int r = prow + 64 * k, tok = t0 - 3 + r; u32x4 v = (u32x4){0u, 0u, 0u, 0u};
          if (r < 131 && tok >= 0) v = *(const u32x4*)(zb + (size_t)tok * 3072 + 512);
          if (r < 131) *(LAS u32x4*)(XR + r * 64 + (tid & 7) * 8) = v; }
      if (FINAL) {
#pragma unroll
          for (int k = 0; k < 2; ++k) pfy[k] = *(const u32x4*)(zb + (size_t)(t0 + prow + 64 * k) * 3072); } }
    __syncthreads();
    const float cw0 = TAB[c], cw1 = TAB[64 + c], cw2 = TAB[128 + c], cw3 = TAB[192 + c], cbv = TAB[256 + c];
    for (int tile = 0; tile < 16; ++tile) {
        const int t0 = seg * 2048 + tile * 128; const bool more = tile + 1 < 16;
        if (more) {
#pragma unroll
            for (int k = 0; k < 3; ++k) { const int r = prow + 64 * k; if (r < 131) pfx[k] = *(const u32x4*)(zb + (size_t)(t0 + 128 - 3 + r) * 3072 + 512); }
        }
#pragma unroll
        for (int i = 0; i < 16; ++i) { const int t = sub + 8 * i;
            const float xc = cbv + cw0 * bf2f(XR[t * 64 + c]) + cw1 * bf2f(XR[(t + 1) * 64 + c]) + cw2 * bf2f(XR[(t + 2) * 64 + c]) + cw3 * bf2f(XR[(t + 3) * 64 + c]);
            XC[t * 72 + c] = f2bf(xc); }
        __syncthreads();
        if (FINAL) {
#pragma unroll
            for (int k = 0; k < 2; ++k) *(LAS u32x4*)(YT + (prow + 64 * k) * 64 + (tid & 7) * 8) = pfy[k];
            if (more) {
#pragma unroll
                for (int k = 0; k < 2; ++k) pfy[k] = *(const u32x4*)(zb + (size_t)(t0 + 128 + prow + 64 * k) * 3072); }
        }
        {
            f32x4 accA[4], accX[4];
#pragma unroll
            for (int nt = 0; nt < 4; ++nt) { accA[nt] = (f32x4){0.f, 0.f, 0.f, 0.f}; accX[nt] = (f32x4){0.f, 0.f, 0.f, 0.f}; }
#pragma unroll
            for (int k = 0; k < 2; ++k) { const bf16x8 av = *(const LAS bf16x8*)(XC + (w * 16 + (lane & 15)) * 72 + k * 32 + 8 * (lane >> 4));
#pragma unroll
                for (int nt = 0; nt < 4; ++nt) { const bf16x8 ba = *(const LAS bf16x8*)(WaT + (nt * 16 + (lane & 15)) * 72 + k * 32 + 8 * (lane >> 4)), bx = *(const LAS bf16x8*)(WxT + (nt * 16 + (lane & 15)) * 72 + k * 32 + 8 * (lane >> 4));
                    accA[nt] = __builtin_amdgcn_mfma_f32_16x16x32_bf16(av, ba, accA[nt], 0, 0, 0); accX[nt] = __builtin_amdgcn_mfma_f32_16x16x32_bf16(av, bx, accX[nt], 0, 0, 0); } }
#pragma unroll
            for (int nt = 0; nt < 4; ++nt) { const int cc = nt * 16 + (lane & 15);
                const float k0 = TAB[cc], k1 = TAB[64 + cc], k2 = TAB[128 + cc], k3 = TAB[192 + cc], kb = TAB[256 + cc], ba = TAB[320 + cc], bx = TAB[384 + cc], spl = TAB[448 + cc];
#pragma unroll
                for (int j = 0; j < 4; ++j) { const int t = w * 16 + 4 * (lane >> 4) + j;
                    const float r = sigmoidf_(accA[nt][j] + ba), ig = sigmoidf_(accX[nt][j] + bx);
                    const float av = __expf(-8.0f * r * spl);
                    const float xc = kb + k0 * bf2f(XR[t * 64 + cc]) + k1 * bf2f(XR[(t + 1) * 64 + cc]) + k2 * bf2f(XR[(t + 2) * 64 + cc]) + k3 * bf2f(XR[(t + 3) * 64 + cc]);
                    AA[t * 64 + cc] = av; UU[t * 64 + cc] = __builtin_amdgcn_sqrtf(fmaxf(1.0f - av * av, 0.f)) * (ig * xc); }
            }
        }
        __syncthreads();
        if (more) {
#pragma unroll
            for (int k = 0; k < 3; ++k) { const int r = prow + 64 * k; if (r < 131) *(LAS u32x4*)(XR + r * 64 + (tid & 7) * 8) = pfx[k]; }
        }
        { float P = 1.f, Hh = 0.f;
#pragma unroll
          for (int i = 0; i < 16; ++i) { const int t = sub * 16 + i; const float a_ = AA[t * 64 + c], u_ = UU[t * 64 + c]; Hh = a_ * Hh + u_; P *= a_; }
          SPp[sub * 64 + c] = P; SHh[sub * 64 + c] = Hh; }
        __syncthreads();
        float hin = h;
#pragma unroll
        for (int s = 0; s < 8; ++s) { const float p = SPp[s * 64 + c], q = SHh[s * 64 + c]; if (s < sub) hin = p * hin + q; h = p * h + q; Ptot *= p; }
        if (FINAL) {
            float hh = hin;
#pragma unroll
            for (int i = 0; i < 16; ++i) { const int t = sub * 16 + i;
                hh = AA[t * 64 + c] * hh + UU[t * 64 + c];
                const float y = bf2f(YT[t * 64 + c]);
                YT[t * 64 + c] = f2bf(y * hh); }
            __syncthreads();
#pragma unroll
            for (int k = 0; k < 2; ++k) { const int r = prow + 64 * k;
                *(u32x4*)(mix + ((size_t)b * TSEQ + t0 + r) * 1024 + cb * 64 + (tid & 7) * 8) = *(const LAS u32x4*)(YT + r * 64 + (tid & 7) * 8); }
        }
    }
    if (!FINAL && sub == 0) *(f32x2*)(agg + ((size_t)((b * 4 + seg) * 512 + cb * 64 + c)) * 2) = (f32x2){Ptot, h};
    __syncthreads();
}

template <bool FINAL>
DI void hgrn_item(LAS unsigned char* lds, const Args& a, int it) {
    const int tid = tid_(), lane = tid & 63, w = tid >> 6, l15 = lane & 15, q4 = lane >> 4;
    const int bh = it >> 3, seg = it & 7, b = bh >> 2, hd = bh & 3;
    const bf16_t* z = (const bf16_t*)(a.ws + WS_Z); bf16_t* mix = (bf16_t*)(a.ws + WS_MIX);
    float* HGS = (float*)(a.ws + WS_HGS); float* HGD = (float*)(a.ws + WS_HGD);
    LAS bf16_t* QS = (LAS bf16_t*)lds;
    LAS bf16_t* KS = QS + 64 * 136;
    LAS bf16_t* KSt = KS + 64 * 136;
    LAS bf16_t* Vt = KSt + 128 * 72;
    LAS bf16_t* Pm = Vt + 128 * 72;
    LAS bf16_t* St = Pm + 64 * 72;
    LAS float* CS = (LAS float*)(St + 128 * 136);
    LAS float* EM = CS + 512; LAS float* EL = EM + 128; LAS float* DEC = EL + 128; LAS float* GN = DEC + 128;
    LAS bf16_t* RV = (LAS bf16_t*)(GN + 128);
    LAS bf16_t* RF = Pm;
    LAS bf16_t* RQ = RF + 64 * 128;
    LAS float* OB = (LAS float*)lds;
    static_assert((64 * 136 * 2 + 128 * 72 * 2 + 64 * 72 + 128 * 136) * 2 + (512 + 128 * 4) * 4 + 64 * 128 * 2 <= 158720, "hgrn lds");
    static_assert(64 * 132 * 4 <= 64 * 136 * 2 * 2 && 2 * 64 * 128 <= 64 * 72 + 128 * 136, "hgrn aliases");
    const int dk = tid & 127, sub = tid >> 7;
    float lbv;
    { const float* lg = a.in[12]; const int col = hd * 128 + dk; const float l0 = lg[col], l1 = lg[512 + col], l2 = lg[1024 + col];
      const float mx = fmaxf(l0, fmaxf(l1, l2)); const float e0 = __expf(l0 - mx), e1 = __expf(l1 - mx), e2 = __expf(l2 - mx); lbv = e0 / (e0 + e1 + e2); }
    if (tid < 128) GN[tid] = a.in[13][tid];
    f32x4 Sacc[8];
#pragma unroll
    for (int nt = 0; nt < 8; ++nt) Sacc[nt] = (f32x4){0.f, 0.f, 0.f, 0.f};
    if (FINAL) for (int j = 0; j < seg; ++j) { const int itj = bh * 8 + j;
#pragma unroll
        for (int nt = 0; nt < 8; ++nt) { const float d = HGD[(size_t)itj * 128 + nt * 16 + l15];
            const f32x4 sj = *(const f32x4*)(HGS + (size_t)itj * 16384 + (size_t)((w * 8 + nt) * 64 + lane) * 4); Sacc[nt] = Sacc[nt] * d + sj; } }
    float dtot = 1.f;
    const size_t tok0 = (size_t)b * TSEQ + seg * 1024;
    const bf16_t* zbase = z + (tok0 + (tid >> 4)) * 3072 + hd * 128 + (tid & 15) * 8;
    const int roff = (tid >> 4) * 128 + (tid & 15) * 8;
    u32x4 pf_f[2], pf_v[2], pf_q[2];
#pragma unroll
    for (int k = 0; k < 2; ++k) { const bf16_t* p = zbase + (size_t)(32 * k) * 3072; pf_f[k] = *(const u32x4*)(p + 1536); pf_v[k] = *(const u32x4*)(p + 2048); if (FINAL) pf_q[k] = *(const u32x4*)(p + 1024); }
#pragma unroll
    for (int k = 0; k < 2; ++k) { *(LAS u32x4*)(RF + roff + k * 4096) = pf_f[k]; *(LAS u32x4*)(RV + roff + k * 4096) = pf_v[k]; if (FINAL) *(LAS u32x4*)(RQ + roff + k * 4096) = pf_q[k]; }
    __syncthreads();
    for (int ck = 0; ck < 16; ++ck) {
        const size_t rowbase = tok0 + ck * 64;
        const bool more = ck + 1 < 16;
        if (more) {
#pragma unroll
            for (int k = 0; k < 2; ++k) { const bf16_t* p = zbase + (size_t)((ck + 1) * 64 + 32 * k) * 3072; pf_f[k] = *(const u32x4*)(p + 1536); pf_v[k] = *(const u32x4*)(p + 2048); if (FINAL) pf_q[k] = *(const u32x4*)(p + 1024); }
        }
        float pf[16], kf[16];
        { float run = 1.f;
#pragma unroll
          for (int i = 0; i < 16; ++i) { const float fl = bf2f(RF[(sub * 16 + i) * 128 + dk]);
              const float f = lbv + (1.0f - lbv) * sigmoidf_(fl); kf[i] = 1.0f - f; run *= f; pf[i] = run; }
          CS[sub * 128 + dk] = run; }
        __syncthreads();
        {
            const float c0 = CS[dk], c1 = CS[128 + dk], c2 = CS[256 + dk], c3 = CS[384 + dk];
            const float offs = (sub > 0 ? c0 : 1.f) * (sub > 1 ? c1 : 1.f) * (sub > 2 ? c2 : 1.f);
            const float pmid = c0 * c1, plast = pmid * c2 * c3; const float rpmid = __builtin_amdgcn_rcpf(pmid);
#pragma unroll
            for (int i = 0; i < 16; ++i) { const int s = sub * 16 + i; const float P = offs * pf[i];
                const bf16_t ks = f2bf(kf[i] * pmid * __builtin_amdgcn_rcpf(P));
                KSt[dk * 72 + s] = ks; Vt[dk * 72 + s] = RV[s * 128 + dk];
                if (FINAL) { KS[s * 136 + dk] = ks; const float q = bf2f(RQ[s * 128 + dk]); QS[s * 136 + dk] = f2bf(q * (P * rpmid)); } }
            if (sub == 0) { EM[dk] = pmid; EL[dk] = c2 * c3; DEC[dk] = plast; }
            dtot *= plast;
        }
        __syncthreads();
        f32x4 oacc[4];
        if (FINAL) {
#pragma unroll
            for (int nt = 0; nt < 8; ++nt) { const float em = EM[nt * 16 + l15];
#pragma unroll
                for (int j = 0; j < 4; ++j) St[(16 * w + 4 * q4 + j) * 136 + nt * 16 + l15] = f2bf(Sacc[nt][j] * em); }
            { const int mt = w >> 1, n0 = (w & 1) * 2; f32x4 sc0 = (f32x4){0.f, 0.f, 0.f, 0.f}, sc1 = sc0;
#pragma unroll
              for (int k = 0; k < 4; ++k) { const bf16x8 av = *(const LAS bf16x8*)(QS + (mt * 16 + l15) * 136 + k * 32 + 8 * q4);
                  const bf16x8 b0 = *(const LAS bf16x8*)(KS + (n0 * 16 + l15) * 136 + k * 32 + 8 * q4), b1 = *(const LAS bf16x8*)(KS + ((n0 + 1) * 16 + l15) * 136 + k * 32 + 8 * q4);
                  sc0 = __builtin_amdgcn_mfma_f32_16x16x32_bf16(av, b0, sc0, 0, 0, 0); sc1 = __builtin_amdgcn_mfma_f32_16x16x32_bf16(av, b1, sc1, 0, 0, 0); }
#pragma unroll
              for (int j = 0; j < 4; ++j) { const int t = mt * 16 + 4 * q4 + j, s0 = n0 * 16 + l15, s1 = s0 + 16;
                  Pm[t * 72 + s0] = (s0 <= t) ? f2bf(sc0[j]) : (bf16_t)0; Pm[t * 72 + s1] = (s1 <= t) ? f2bf(sc1[j]) : (bf16_t)0; } }
            __syncthreads();
#pragma unroll
            for (int m4 = 0; m4 < 4; ++m4) oacc[m4] = (f32x4){0.f, 0.f, 0.f, 0.f};
#pragma unroll
            for (int k = 0; k < 2; ++k) { const bf16x8 bv = *(const LAS bf16x8*)(Vt + (16 * w + l15) * 72 + k * 32 + 8 * q4);
#pragma unroll
                for (int m4 = 0; m4 < 4; ++m4) { const bf16x8 av = *(const LAS bf16x8*)(Pm + (m4 * 16 + l15) * 72 + k * 32 + 8 * q4); oacc[m4] = __builtin_amdgcn_mfma_f32_16x16x32_bf16(av, bv, oacc[m4], 0, 0, 0); } }
#pragma unroll
            for (int k = 0; k < 4; ++k) { const bf16x8 bv = *(const LAS bf16x8*)(St + (16 * w + l15) * 136 + k * 32 + 8 * q4);
#pragma unroll
                for (int m4 = 0; m4 < 4; ++m4) { const bf16x8 av = *(const LAS bf16x8*)(QS + (m4 * 16 + l15) * 136 + k * 32 + 8 * q4); oacc[m4] = __builtin_amdgcn_mfma_f32_16x16x32_bf16(av, bv, oacc[m4], 0, 0, 0); } }
        } else if (more) {
#pragma unroll
            for (int k = 0; k < 2; ++k) { *(LAS u32x4*)(RF + roff + k * 4096) = pf_f[k]; *(LAS u32x4*)(RV + roff + k * 4096) = pf_v[k]; }
        }
        {
            f32x4 kv[8];
#pragma unroll
            for (int nt = 0; nt < 8; ++nt) kv[nt] = (f32x4){0.f, 0.f, 0.f, 0.f};
#pragma unroll
            for (int k = 0; k < 2; ++k) { const bf16x8 av = *(const LAS bf16x8*)(Vt + (16 * w + l15) * 72 + k * 32 + 8 * q4);
#pragma unroll
                for (int nt = 0; nt < 8; ++nt) { const bf16x8 bv = *(const LAS bf16x8*)(KSt + (nt * 16 + l15) * 72 + k * 32 + 8 * q4); kv[nt] = __builtin_amdgcn_mfma_f32_16x16x32_bf16(av, bv, kv[nt], 0, 0, 0); } }
#pragma unroll
            for (int nt = 0; nt < 8; ++nt) { const float dec = DEC[nt * 16 + l15], el = EL[nt * 16 + l15]; Sacc[nt] = Sacc[nt] * dec + kv[nt] * el; }
        }
        if (FINAL) {
            __syncthreads();
#pragma unroll
            for (int m4 = 0; m4 < 4; ++m4)
#pragma unroll
                for (int j = 0; j < 4; ++j) OB[(m4 * 16 + 4 * q4 + j) * 132 + 16 * w + l15] = oacc[m4][j];
            if (more) {
#pragma unroll
                for (int k = 0; k < 2; ++k) { *(LAS u32x4*)(RF + roff + k * 4096) = pf_f[k]; *(LAS u32x4*)(RV + roff + k * 4096) = pf_v[k]; *(LAS u32x4*)(RQ + roff + k * 4096) = pf_q[k]; }
            }
            __syncthreads();
            const int t = tid >> 3, part = tid & 7; const size_t row = rowbase + t;
            f32x4 o[4]; float ss = 0.f;
#pragma unroll
            for (int i = 0; i < 4; ++i) { o[i] = *(const LAS f32x4*)(OB + t * 132 + part * 16 + i * 4); ss += (o[i][0] * o[i][0] + o[i][1] * o[i][1]) + (o[i][2] * o[i][2] + o[i][3] * o[i][3]); }
            ss += __shfl_xor(ss, 1); ss += __shfl_xor(ss, 2); ss += __shfl_xor(ss, 4);
            const float rstd = rsqrtf(ss * (1.0f / 128.0f) + 1e-6f);
            const u32x4* gp = (const u32x4*)(z + row * 3072 + 2560 + hd * 128 + part * 16); u32x4* op = (u32x4*)(mix + row * 1024 + 512 + hd * 128 + part * 16);
#pragma unroll
            for (int hh = 0; hh < 2; ++hh) { const u32x4 gw = gp[hh]; u32x4 ow;
#pragma unroll
                for (int e = 0; e < 4; ++e) { const unsigned gword = gw[e]; const int i0 = hh * 8 + e * 2;
                    const float v0 = o[i0 >> 2][i0 & 3] * rstd * GN[part * 16 + i0] * bflo(gword);
                    const float v1 = o[(i0 + 1) >> 2][(i0 + 1) & 3] * rstd * GN[part * 16 + i0 + 1] * bfhi(gword);
                    ow[e] = cvt_pk_bf16(v0, v1); }
                op[hh] = ow; }
        } else {
            __syncthreads();
        }
    }
    if (!FINAL) {
#pragma unroll
        for (int nt = 0; nt < 8; ++nt) *(f32x4*)(HGS + (size_t)it * 16384 + (size_t)((w * 8 + nt) * 64 + lane) * 4) = Sacc[nt];
        if (sub == 0) HGD[(size_t)it * 128 + dk] = dtot;
    }
    __syncthreads();
}

template <bool FINAL> DI void phase_mixer0(LAS unsigned char* lds, const Args& a) {
#ifndef NO_HG
    for (int it = bid_(); it < 256; it += (int)gridDim.x) hgrn_item<FINAL>(lds, a, it);
#endif
#ifndef NO_LRU
    for (int it = bid_(); it < 256; it += (int)gridDim.x) lru_item<FINAL>(lds, a, it);
#endif
}

DI void phase_sgu(LAS unsigned char* lds, const Args& a) {
    const int tid = tid_(), lane = tid & 63, w = tid >> 6, c8 = tid & 15;
    const bf16_t* uv = (const bf16_t*)(a.ws + WS_UV); bf16_t* sg = (bf16_t*)(a.ws + WS_SG); const bf16_t* wsc = (const bf16_t*)(a.ws + WS_WSC); const float* vst = (const float*)(a.ws + WS_VST);
    LAS bf16_t* WC = (LAS bf16_t*)lds;
    LAS bf16_t* VnT = WC + 128 * 136;
    LAS float* MU = (LAS float*)(VnT + 128 * 136); LAS float* RS = MU + 128;
    LAS float* OT = (LAS float*)(lds + 70656);
    const int G = (int)gridDim.x;
    int cur_g = -1; float lg[8], lb8[8];
#pragma unroll
    for (int e = 0; e < 8; ++e) { lg[e] = 0.f; lb8[e] = 0.f; }
    u32x4 raw[4]; float mu_r = 0.f, rs_r = 0.f;
    int it = bid_();
    if (it < 4096) { const size_t rb = (size_t)(it >> 3) * 128; const int g = it & 7;
#pragma unroll
        for (int i = 0; i < 4; ++i) raw[i] = *(const u32x4*)(uv + (rb + (tid >> 4) + 32 * i) * 2048 + 1024 + g * 128 + c8 * 8);
        if (tid < 128) { const size_t row = rb + tid; float s1 = 0.f, s2 = 0.f;
#pragma unroll
            for (int p = 0; p < 16; ++p) { const f32x2 q = *(const f32x2*)(vst + (row * 16 + p) * 2); s1 += q[0]; s2 += q[1]; }
            mu_r = s1 * (1.0f / 1024.0f); rs_r = rsqrtf(fmaxf(s2 * (1.0f / 1024.0f) - mu_r * mu_r, 0.f) + 1e-6f); } }
    for (; it < 4096; it += G) {
        const int g = it & 7; const size_t rowbase = (size_t)(it >> 3) * 128;
        if (g != cur_g) { cur_g = g;
#pragma unroll
            for (int r = 0; r < 4; ++r) { const int e = tid + 512 * r, t = e >> 4, ch = e & 15; *(LAS u32x4*)(WC + t * 136 + ch * 8) = *(const u32x4*)(wsc + g * 16384 + t * 128 + ch * 8); }
#pragma unroll
            for (int e = 0; e < 8; ++e) { lg[e] = a.in[17][g * 128 + c8 * 8 + e]; lb8[e] = a.in[18][g * 128 + c8 * 8 + e]; } }
        if (tid < 128) { MU[tid] = mu_r; RS[tid] = rs_r; }
        u32x4 cur[4];
#pragma unroll
        for (int i = 0; i < 4; ++i) cur[i] = raw[i];
        __syncthreads();
        { const int nit = it + G;
          if (nit < 4096) { const size_t rb = (size_t)(nit >> 3) * 128; const int gn = nit & 7;
#pragma unroll
              for (int i = 0; i < 4; ++i) raw[i] = *(const u32x4*)(uv + (rb + (tid >> 4) + 32 * i) * 2048 + 1024 + gn * 128 + c8 * 8);
              if (tid < 128) { const size_t row = rb + tid; float s1 = 0.f, s2 = 0.f;
#pragma unroll
                  for (int p = 0; p < 16; ++p) { const f32x2 q = *(const f32x2*)(vst + (row * 16 + p) * 2); s1 += q[0]; s2 += q[1]; }
                  mu_r = s1 * (1.0f / 1024.0f); rs_r = rsqrtf(fmaxf(s2 * (1.0f / 1024.0f) - mu_r * mu_r, 0.f) + 1e-6f); } } }
        u32x4 uq[4];
#pragma unroll
        for (int i = 0; i < 4; ++i) uq[i] = *(const u32x4*)(uv + (rowbase + 16 * w + (lane >> 4) + 4 * i) * 2048 + g * 128 + (lane & 15) * 8);
#pragma unroll
        for (int i = 0; i < 4; ++i) { const int s = (tid >> 4) + 32 * i; const u32x4 rw = cur[i];
            const float mu = MU[s], rs = RS[s];
#pragma unroll
            for (int e = 0; e < 4; ++e) { const float v0 = (bflo(rw[e]) - mu) * rs * lg[2 * e] + lb8[2 * e], v1 = (bfhi(rw[e]) - mu) * rs * lg[2 * e + 1] + lb8[2 * e + 1];
                VnT[(c8 * 8 + 2 * e) * 136 + s] = f2bf(v0); VnT[(c8 * 8 + 2 * e + 1) * 136 + s] = f2bf(v1); } }
        __syncthreads();
        f32x4 acc[8];
#pragma unroll
        for (int nt = 0; nt < 8; ++nt) acc[nt] = (f32x4){0.f, 0.f, 0.f, 0.f};
#pragma unroll
        for (int k = 0; k < 4; ++k) { const bf16x8 av = *(const LAS bf16x8*)(WC + (16 * w + (lane & 15)) * 136 + k * 32 + 8 * (lane >> 4));
#pragma unroll
            for (int nt = 0; nt < 8; ++nt) { const bf16x8 bv = *(const LAS bf16x8*)(VnT + (nt * 16 + (lane & 15)) * 136 + k * 32 + 8 * (lane >> 4));
                acc[nt] = __builtin_amdgcn_mfma_f32_16x16x32_bf16(av, bv, acc[nt], 0, 0, 0); } }
#pragma unroll
        for (int nt = 0; nt < 8; ++nt)
#pragma unroll
            for (int j = 0; j < 4; ++j) OT[(16 * w + 4 * (lane >> 4) + j) * 132 + nt * 16 + (lane & 15)] = acc[nt][j];
        asm volatile("s_waitcnt lgkmcnt(0)" ::: "memory");
#pragma unroll
        for (int i = 0; i < 4; ++i) { const int tl = 16 * w + (lane >> 4) + 4 * i; const float bias = a.in[20][g * 128 + tl];
            const f32x4 o0 = *(const LAS f32x4*)(OT + tl * 132 + (lane & 15) * 8), o1 = *(const LAS f32x4*)(OT + tl * 132 + (lane & 15) * 8 + 4);
            const u32x4 uu = uq[i]; u32x4 ow;
            ow.x = cvt_pk_bf16(bflo(uu.x) * (o0[0] + bias), bfhi(uu.x) * (o0[1] + bias)); ow.y = cvt_pk_bf16(bflo(uu.y) * (o0[2] + bias), bfhi(uu.y) * (o0[3] + bias));
            ow.z = cvt_pk_bf16(bflo(uu.z) * (o1[0] + bias), bfhi(uu.z) * (o1[1] + bias)); ow.w = cvt_pk_bf16(bflo(uu.w) * (o1[2] + bias), bfhi(uu.w) * (o1[3] + bias));
            *(u32x4*)(sg + (rowbase + tl) * 1024 + g * 128 + (lane & 15) * 8) = ow; }
        __syncthreads();
    }
}

DI void phase_final(const Args& a) {
    const int tid = tid_(), lane = tid & 63, wave = tid >> 6;
    const int gw = bid_() * 8 + wave, NGW = (int)gridDim.x * 8;
    const float* ssq = (const float*)(a.ws + WS_SSQ); const float* gn = a.in[3]; const bf16_t* hb = (const bf16_t*)(a.ws + WS_HB);
    f32x4 gv[4];
#pragma unroll
    for (int j = 0; j < 4; ++j) gv[j] = *((const f32x4*)gn + lane + 64 * j);
    for (int m = gw; m < MTOK; m += NGW) {
        const float rs = ssq_rs(ssq, (size_t)m);
        const u32x2* hp = (const u32x2*)(hb + (size_t)m * DM) + lane; f32x4* p = (f32x4*)(a.out + (size_t)m * DM) + lane;
#pragma unroll
        for (int j = 0; j < 4; ++j) { const u32x2 r = hp[64 * j]; const f32x4 v = (f32x4){bflo(r.x), bfhi(r.x), bflo(r.y), bfhi(r.y)}; p[64 * j] = v * rs * gv[j]; }
    }
}

#define XB_TMO      128
#define XB_XCNT(j)  (256  + 64 * (j))
#define XB_XSUB(j)  (1280 + 64 * (j))
#define XB_XGEN(j)  (2304 + 64 * (j))
#define XB_TOP      3328
#define XB_TOPGEN   3392
#define XCD_BAR_WORDS 3456
#define XB_SPIN_CAP (1u << 22)
DI unsigned xb_ld(unsigned* p)              { return __hip_atomic_load(p, __ATOMIC_RELAXED, __HIP_MEMORY_SCOPE_AGENT); }
DI unsigned xb_add(unsigned* p, unsigned v) { return __hip_atomic_fetch_add(p, v, __ATOMIC_RELAXED, __HIP_MEMORY_SCOPE_AGENT); }
DI unsigned xb_xcc_id() { return (unsigned)__builtin_amdgcn_s_getreg((3 << 11) | 20) & 0xFu; }
#define XB_SPIN(cond, bar) do { unsigned _sp = 0; while (cond) { __builtin_amdgcn_s_sleep(1); \
    if ((++_sp & 255u) == 0u) { if (xb_ld(&(bar)[XB_TMO])) break; if (_sp > XB_SPIN_CAP) { atomicAdd(&(bar)[XB_TMO], 1u); break; } } } } while (0)
struct XcdBarrier { unsigned* bar; unsigned x; volatile LAS unsigned* st; };
DI XcdBarrier xcd_barrier_post(unsigned* bar, volatile LAS unsigned* st) {
    XcdBarrier b; b.bar = bar; b.x = xb_xcc_id(); b.st = st;
    if (threadIdx.x == 0) (void)xb_add(&bar[XB_XCNT(b.x)], 1u);
    return b;
}
DI void xcd_barrier_complete(unsigned* bar, unsigned x, unsigned& nloc, unsigned& nx) {
    const unsigned G = gridDim.x * gridDim.y * gridDim.z;
    unsigned sum, cnt, mine, sp = 0u;
    for (;;) {
        sum = 0u; cnt = 0u; mine = 0u;
#pragma unroll
        for (unsigned j = 0; j < 16; ++j) { const unsigned c = xb_ld(&bar[XB_XCNT(j)]); sum += c; cnt += (c > 0u) ? 1u : 0u; mine = (j == x) ? c : mine; }
        if (sum == G) break;
        __builtin_amdgcn_s_sleep(1);
        if ((++sp & 255u) == 0u) { if (xb_ld(&bar[XB_TMO])) break; if (sp > XB_SPIN_CAP) { atomicAdd(&bar[XB_TMO], 1u); break; } }
    }
    nloc = mine > 0u ? mine : 1u; nx = cnt > 0u ? cnt : 1u;
}
DI void xcd_barrier(const XcdBarrier& b) {
    asm volatile("s_waitcnt vmcnt(0)" ::: "memory");
    __syncthreads();
    if (threadIdx.x == 0) {
        unsigned* bar = b.bar;
        __builtin_amdgcn_s_waitcnt(0);
        unsigned nloc = b.st[0], nx = b.st[1];
        if (nloc == 0u) { xcd_barrier_complete(bar, b.x, nloc, nx); b.st[0] = nloc; b.st[1] = nx; }
        const unsigned old = xb_add(&bar[XB_XSUB(b.x)], 1u);
        const unsigned gen = old / nloc;
        if (old + 1u == (gen + 1u) * nloc) {
            __builtin_amdgcn_fence(__ATOMIC_RELEASE, "agent");
            asm volatile("s_waitcnt vmcnt(0)" ::: "memory");
            const unsigned og = xb_add(&bar[XB_TOP], 1u);
            const unsigned tg = og / nx;
            if (og + 1u == (tg + 1u) * nx) xb_add(&bar[XB_TOPGEN], 1u);
            else XB_SPIN(xb_ld(&bar[XB_TOPGEN]) == tg, bar);
            __builtin_amdgcn_fence(__ATOMIC_ACQUIRE, "agent");
            xb_add(&bar[XB_XGEN(b.x)], 1u);
            asm volatile("s_waitcnt vmcnt(0)" ::: "memory");
        } else {
            XB_SPIN(xb_ld(&bar[XB_XGEN(b.x)]) == gen, bar);
            __builtin_amdgcn_fence(__ATOMIC_ACQUIRE, "agent");
            asm volatile("s_waitcnt vmcnt(0)" ::: "memory");
        }
    }
    __syncthreads();
}

constexpr int NPHASE = 13;
#ifndef REP_MASK
#define REP_MASK 0
#endif
#ifndef USE_CG_SYNC
#define USE_CG_SYNC 0
#endif
#ifndef PH_MASK
#define PH_MASK 0xFFFF
#endif
#define PHM(k) (((PH_MASK) >> (k)) & 1)
__global__ void __launch_bounds__(NTHR, 2) mk_fwd(Args a) {
    extern __shared__ __attribute__((aligned(16))) unsigned char lds_raw[];
    LAS unsigned char* lds = (LAS unsigned char*)lds_raw;
    unsigned char* ws = a.ws;
    bf16_t* hb = (bf16_t*)(ws + WS_HB); float* ssq = (float*)(ws + WS_SSQ); float* H = a.out;
    volatile LAS unsigned* bst = (volatile LAS unsigned*)(lds + 131072 + 4096 + 23552);
    if (threadIdx.x < 4) bst[threadIdx.x] = 0u;
    __syncthreads();
    XcdBarrier xb = xcd_barrier_post((unsigned*)ws, bst);
    if (threadIdx.x == 0) { const unsigned xcc = xb.x & 7u; bst[2] = xcc; bst[3] = xb_add((unsigned*)ws + 4096 + 64 * xcc, 1u); }
    int vc = (int)blockIdx.x; bool vc_done = false;
    for (int pi = a.ph_lo; pi < a.ph_hi; ++pi) {
        const int ph = a.seq[pi];
        if (pi > 0 && !vc_done) {
            if (threadIdx.x == 0) { bool ok = (gridDim.x % 8u) == 0u;
                for (unsigned j = 0; j < 8; ++j) ok = ok && (xb_ld((unsigned*)ws + 4096 + 64 * j) == gridDim.x / 8u);
                bst[2] = ok ? (bst[2] + 8u * bst[3]) : blockIdx.x; }
            __syncthreads(); vc = __builtin_amdgcn_readfirstlane((int)bst[2]); vc_done = true;
        }
        if (PHM(0) && ph == 0) phase_prep(lds, a);
        else if (PHM(1) && ph == 1) { EpiScale E{(bf16_t*)(ws + WS_Z), 3072, (const LAS float*)(lds + RST_OFF)}; run_gemm(lds, vc, hb, (const bf16_t*)(ws + WS_WIN0), MTOK, 3072, 1024, E, ssq); }
        else if (PHM(2) && ph == 2) phase_mixer0<false>(lds, a);
        else if (PHM(3) && ph == 3) phase_mixer0<true>(lds, a);
        else if (PHM(4) && (ph == 4 || ph == 9)) {
            EpiRes E{hb, ssq};
            run_gemm(lds, vc, (const bf16_t*)(ws + (ph == 4 ? WS_MIX : WS_SG)), (const bf16_t*)(ws + (ph == 4 ? WS_WOUT0 : WS_WOUT1)), MTOK, 1024, 1024, E);
        }
        else if (PHM(5) && ph == 7) { EpiGelu E{(bf16_t*)(ws + WS_UV), 2048, (const LAS float*)(lds + RST_OFF), a.in[16], (float*)(ws + WS_VST)}; run_gemm(lds, vc, hb, (const bf16_t*)(ws + WS_WIN1), MTOK, 2048, 1024, E, ssq); }
        else if (PHM(6) && ph == 8) phase_sgu(lds, a);
        else if (PHM(7) && ph == 12) phase_final(a);
        else if (PHM(8) && (ph == 5 || ph == 10)) {
            const int layer = (ph == 10);
            EpiFfn E{(bf16_t*)(ws + WS_ACT), (const LAS float*)(lds + RST_OFF), a.in[23] + (size_t)layer * 3 * DFF, a.in[24] + (size_t)layer * DFF, (LAS float*)(lds + 131072)};
            run_gemm_ffn(lds, vc, hb, (const bf16_t*)(ws + (layer ? WS_WUP1 : WS_WUP0)), ssq, E);
        }
        else if (PHM(9) && (ph == 6 || ph == 11)) {
            const int layer = (ph == 11);
            EpiRes E{hb, ssq}; run_gemm(lds, vc, (const bf16_t*)(ws + WS_ACT), (const bf16_t*)(ws + (layer ? WS_WDN1 : WS_WDN0)), MTOK, 1024, DFF, E);
        }
        if (pi + 1 < a.ph_hi) {
            if (USE_CG_SYNC || a.ph_hi > 1000) { __threadfence(); cg::this_grid().sync(); }
            else xcd_barrier(xb);
        }
    }
}

extern "C" void kernel_launch(void* const* d_in, const int* in_sizes, int n_in, void* d_out, int out_size, void* d_ws, size_t ws_size, hipStream_t stream) {
    static int grid = 0;
    if (grid == 0) {
        if (n_in != 26 || ws_size < WS_END) { fprintf(stderr, "kernel_launch: unexpected n_in %d / ws_size %zu (need %zu)\n", n_in, ws_size, (size_t)WS_END); grid = -1; return; }
        int dev = 0, cus = 0, per_cu = 0;
        (void)hipGetDevice(&dev); (void)hipDeviceGetAttribute(&cus, hipDeviceAttributeMultiprocessorCount, dev);
        if (hipFuncSetAttribute((const void*)mk_fwd, hipFuncAttributeMaxDynamicSharedMemorySize, LDS_BYTES) != hipSuccess) { fprintf(stderr, "kernel_launch: hipFuncSetAttribute failed\n"); grid = -1; return; }
        if (hipOccupancyMaxActiveBlocksPerMultiprocessor(&per_cu, (const void*)mk_fwd, NTHR, LDS_BYTES) != hipSuccess || per_cu < 1) { fprintf(stderr, "kernel_launch: occupancy query gave %d\n", per_cu); per_cu = 1; }
        (void)hipGetLastError();
        grid = cus * per_cu;
    }
    if (grid < 0) return;
    Args a{};
    for (int i = 0; i < 26; ++i) a.in[i] = (const float*)d_in[i];
    a.out = (float*)d_out; a.ws = (unsigned char*)d_ws;
#if ONE_LAUNCH
    { int n = 0; for (int ph = 0; ph < NPHASE; ++ph) { a.seq[n++] = ph; if ((REP_MASK >> ph) & 1) a.seq[n++] = ph; } a.ph_lo = 0; a.ph_hi = n; }
    if (hipMemsetAsync(d_ws, 0, 32768, stream) != hipSuccess) { fprintf(stderr, "kernel_launch: memset of the barrier words failed\n"); return; }
    void* args[] = {&a};
    hipError_t e = hipLaunchCooperativeKernel((const void*)mk_fwd, dim3(grid), dim3(NTHR), args, LDS_BYTES, stream);
    if (e != hipSuccess) fprintf(stderr, "cooperative launch failed: %s (grid %d)\n", hipGetErrorString(e), grid);
#else
    for (int ph = 0; ph < NPHASE; ++ph) {
        a.seq[0] = ph; a.ph_lo = 0; a.ph_hi = 1;
        hipLaunchKernelGGL(mk_fwd, dim3(grid), dim3(NTHR), LDS_BYTES, stream, a);
    }
#endif
}
```

```cpp
#include <hip/hip_runtime.h>
#include <hip/hip_cooperative_groups.h>
#include <cstdio>
namespace cg = cooperative_groups;

#ifndef ONE_LAUNCH
#define ONE_LAUNCH 1
#endif

#define LAS __attribute__((address_space(3)))
#define DI __device__ __forceinline__
typedef unsigned short bf16_t;
typedef short bf16x8 __attribute__((ext_vector_type(8)));
typedef float f32x4 __attribute__((ext_vector_type(4)));
typedef float f32x2 __attribute__((ext_vector_type(2)));
typedef unsigned u32x4 __attribute__((ext_vector_type(4)));
typedef unsigned u32x2 __attribute__((ext_vector_type(2)));

constexpr int MTOK = 65536, DM = 1024, TSEQ = 8192, NBATCH = 8, DFF = 2816;
constexpr int LDS_BYTES = 131072 + 4096 + 23552 + 16;
constexpr int NTHR = 512;

constexpr size_t MiB = 1024ull * 1024ull;
constexpr size_t WS_WIN0 = 1 * MiB;
constexpr size_t WS_WOUT0 = WS_WIN0 + 6 * MiB;
constexpr size_t WS_WUP0 = WS_WOUT0 + 2 * MiB;
constexpr size_t WS_WDN0 = WS_WUP0 + 11 * MiB;
constexpr size_t WS_WIN1 = WS_WDN0 + 11 * MiB / 2;
constexpr size_t WS_WOUT1 = WS_WIN1 + 4 * MiB;
constexpr size_t WS_WUP1 = WS_WOUT1 + 2 * MiB;
constexpr size_t WS_WDN1 = WS_WUP1 + 11 * MiB;
constexpr size_t WS_WSC = 48 * MiB;
constexpr size_t WS_SSQ = 49 * MiB;
constexpr size_t WS_VST = 53 * MiB;
constexpr size_t WS_LRUAGG = 61 * MiB;
constexpr size_t WS_HGD = 62 * MiB;
constexpr size_t WS_HGS = 63 * MiB;
constexpr size_t WS_HB = 80 * MiB;
constexpr size_t WS_R1 = 208 * MiB;
constexpr size_t WS_Z = WS_R1;
constexpr size_t WS_MIX = WS_R1 + 384 * MiB;
constexpr size_t WS_ACT = WS_R1;
constexpr size_t WS_UV = WS_R1;
constexpr size_t WS_SG = WS_R1 + 384 * MiB;
constexpr size_t WS_END = WS_R1 + 528 * MiB;

struct Args { const float* in[26]; float* out; unsigned char* ws; int ph_lo, ph_hi; int seq[32]; };

typedef __bf16 bf16x2_t __attribute__((ext_vector_type(2)));
DI unsigned cvt_pk_bf16(float lo, float hi) { const bf16x2_t v = __builtin_convertvector((f32x2){lo, hi}, bf16x2_t); return __builtin_bit_cast(unsigned, v); }
DI bf16_t f2bf(float f) { return (bf16_t)(cvt_pk_bf16(f, 0.f) & 0xffffu); }
DI float bf2f(bf16_t b) { return __builtin_bit_cast(float, (unsigned)b << 16); }
DI float bflo(unsigned w) { return __builtin_bit_cast(float, w << 16); }
DI float bfhi(unsigned w) { return __builtin_bit_cast(float, w & 0xffff0000u); }
DI int tid_() { int t = (int)threadIdx.x; asm volatile("" : "+v"(t)); return t; }
DI int bid_() { int b = __builtin_amdgcn_workgroup_id_x(); asm volatile("" : "+s"(b)); return b; }
DI float sigmoidf_(float x) { return __builtin_amdgcn_rcpf(1.0f + __builtin_amdgcn_exp2f(x * -1.44269504f)); }
DI float siluf_(float x) { return x * sigmoidf_(x); }
DI float geluf_(float x) { const float y = 1.5957691216f * (x + 0.044715f * x * x * x); return x * sigmoidf_(y); }
DI float wave_sum(float v) {
#pragma unroll
    for (int o = 1; o < 64; o <<= 1) v += __shfl_xor(v, o);
    return v;
}
DI f32x4 mma16(const LAS bf16_t* A, int lda, const LAS bf16_t* Bt, int ldb, int K, f32x4 acc, int lane) {
    const LAS bf16_t* a = A + (lane & 15) * lda + 8 * (lane >> 4);
    const LAS bf16_t* b = Bt + (lane & 15) * ldb + 8 * (lane >> 4);
#pragma unroll
    for (int k = 0; k < K; k += 32) {
        const bf16x8 av = *(const LAS bf16x8*)(a + k); const bf16x8 bv = *(const LAS bf16x8*)(b + k);
        acc = __builtin_amdgcn_mfma_f32_16x16x32_bf16(av, bv, acc, 0, 0, 0);
    }
    return acc;
}

namespace pg8 {
constexpr int BM = 256, BK = 64, HALF = 128, HTB = HALF * BK * 2, STAGE_BYTES = 8 * HTB, NXCD = 8, WGM = 8;
DI int lds_byte(int r, int c) { const int st = (r >> 4) * 2 + (c >> 5), rr = r & 15, cc = c & 31, ob = rr * 64 + cc * 2; return st * 1024 + (ob ^ (((ob >> 9) & 1) << 5)); }
DI void stage_rc(int b, int& R, int& C) { const int st = b / 1024, sb = b % 1024, swz = sb ^ (((sb >> 9) & 1) << 5); R = (st >> 1) * 16 + swz / 64; C = (st & 1) * 32 + (swz % 64) / 2; }
DI int perm32(int rho) { const int n = rho >> 4, i = rho & 15; return 8 * (i >> 2) + 4 * n + (i & 3); }
struct Unit { int pm, pn, arow, ord; };
struct Gemm { const bf16_t* A; const bf16_t* Bt; int M, N, K; };
struct StaticOrder {
    int nM, nN, nwg, G, c, ffn;
    DI void init(int M, int N, int G_, int c_) { nM = M / BM; nN = N / BM; nwg = nM * nN; G = G_; c = c_; ffn = 0; }
    DI void init_ffn(int G_, int c_) { nM = 264; nN = 22; nwg = nM * nN; G = G_; c = c_; ffn = 1; }
    DI bool next(int i, Unit& u) const {
        const long L = (long)i * G + c; if (L >= nwg) return false;
        int wgid = (int)L; { const int q = nwg / NXCD, r = nwg % NXCD, xcd = wgid % NXCD, off = wgid / NXCD; wgid = (xcd < r ? xcd * (q + 1) : r * (q + 1) + (xcd - r) * q) + off; }
        const int nig = WGM * nN, gid = wgid / nig, fm = gid * WGM, gsz = (nM - fm) < WGM ? (nM - fm) : WGM;
        u.pm = fm + ((wgid % nig) % gsz); u.pn = (wgid % nig) / gsz;
        if (ffn) { const int bb = u.pm / 33, ii = u.pm - bb * 33; u.arow = bb * 8192 + ii * 254 - 2; } else u.arow = u.pm * BM;
        return true;
    }
};

template <class Epi>
DI void gemm_phase(LAS unsigned char* lds, const Gemm g, const StaticOrder& S, const Epi& E) {
    const int tid = tid_(), wid = __builtin_amdgcn_readfirstlane(tid >> 6), lane = tid & 63, wr = wid >> 2, wc = wid & 3, fr = lane & 15, fq = lane >> 4;
    const int K = g.K, nt = K / BK;
    unsigned voffA[2], voffB[2];
#pragma unroll
    for (int i = 0; i < 2; ++i) { int R, C; stage_rc(tid * 16 + i * 8192, R, C); const int Rb = Epi::PERM ? ((R & ~31) + perm32(R & 31)) : R;
        voffA[i] = (unsigned)(R * K + C) * 2u; voffB[i] = (unsigned)(Rb * K + C) * 2u; }
    const size_t kstep = (size_t)(BK * 2);
    const size_t hstep = (size_t)HALF * K * 2;
    const size_t tstep = 2 * hstep;
    const unsigned ldsw = (unsigned)wid * 1024u;
    const int aoff = lds_byte(wr * 64 + fr, fq * 8), boff = lds_byte(wc * 32 + fr, fq * 8);
#define PG8_SA(b, h) (((b) * 2 + (h)) * HTB)
#define PG8_SB(b, h) ((4 + (b) * 2 + (h)) * HTB)
#define PG8_STAGE(bufoff, gbase, voff) do { _Pragma("unroll") for (int _i = 0; _i < 2; ++_i) \
        __builtin_amdgcn_global_load_lds((const unsigned*)((const char*)(gbase) + (voff)[_i]), (LAS unsigned*)(lds + (bufoff) + ldsw + _i * 8192), 16, 0, 0); } while (0)
#define PG8_LDA(dst, b, h) do { _Pragma("unroll") for (int m = 0; m < 4; ++m) _Pragma("unroll") for (int k = 0; k < 2; ++k) dst[m][k] = *(const LAS bf16x8*)(lds + PG8_SA(b, h) + aoff + m * 2048 + k * 1024); } while (0)
#define PG8_LDB(dst, b, h) do { _Pragma("unroll") for (int n = 0; n < 2; ++n) _Pragma("unroll") for (int k = 0; k < 2; ++k) dst[n][k] = *(const LAS bf16x8*)(lds + PG8_SB(b, h) + boff + n * 2048 + k * 1024); } while (0)
#define PG8_MMA(ai, bj, At, Bt) do { __builtin_amdgcn_s_setprio(1); _Pragma("unroll") for (int m = 0; m < 4; ++m) _Pragma("unroll") for (int n = 0; n < 2; ++n) _Pragma("unroll") for (int k = 0; k < 2; ++k) \
        acc[ai][bj][m][n] = __builtin_amdgcn_mfma_f32_16x16x32_bf16(Bt[n][k], At[m][k], acc[ai][bj][m][n], 0, 0, 0); __builtin_amdgcn_s_setprio(0); } while (0)
#define PG8_WAIT_V(n) asm volatile("s_waitcnt vmcnt(" #n ")" ::: "memory")
#define PG8_WAIT_L(n) asm volatile("s_waitcnt lgkmcnt(" #n ")" ::: "memory")
#define PG8_BAR __builtin_amdgcn_s_barrier()
#define PG8_SCHED __builtin_amdgcn_sched_barrier(0)
    Unit cur, nxt; nxt.pm = 0; nxt.pn = 0; nxt.arow = 0; nxt.ord = 0; int ui = 0;
    if (!S.next(0, cur)) return;
    cur.ord = 0;
    f32x4 acc[2][2][4][2];
#pragma unroll
    for (int a = 0; a < 2; ++a)
#pragma unroll
        for (int b = 0; b < 2; ++b)
#pragma unroll
            for (int m = 0; m < 4; ++m)
#pragma unroll
                for (int n = 0; n < 2; ++n) acc[a][b][m][n] = (f32x4){0.f, 0.f, 0.f, 0.f};
    bf16x8 At[4][2], B0[2][2], B1[2][2];
    const char* cA = (const char*)g.A + (ptrdiff_t)cur.arow * (ptrdiff_t)(K * 2); const char* cB = (const char*)g.Bt + (size_t)cur.pn * tstep;
    PG8_STAGE(PG8_SB(0, 0), cB, voffB); PG8_STAGE(PG8_SA(0, 0), cA, voffA); PG8_STAGE(PG8_SB(0, 1), cB + hstep, voffB); PG8_STAGE(PG8_SA(0, 1), cA + hstep, voffA);
    if (wr == 1) PG8_BAR;
    PG8_WAIT_V(4); PG8_BAR;
    PG8_STAGE(PG8_SB(1, 0), cB + kstep, voffB); PG8_STAGE(PG8_SA(1, 0), cA + kstep, voffA); PG8_STAGE(PG8_SB(1, 1), cB + hstep + kstep, voffB);
    PG8_WAIT_V(6); PG8_BAR;
    for (;;) {
        const bool has_next = S.next(ui + 1, nxt); nxt.ord = ui + 1;
        const char* nA = has_next ? (const char*)g.A + (ptrdiff_t)nxt.arow * (ptrdiff_t)(K * 2) : cA; const char* nB = has_next ? (const char*)g.Bt + (size_t)nxt.pn * tstep : cB;
        for (int t = 0; t < nt; t += 2) {
            const bool last = (t == nt - 2);
            const char* a1 = cA + (size_t)(t + 1) * kstep;
            const char* a2 = last ? nA : cA + (size_t)(t + 2) * kstep; const char* b2 = last ? nB : cB + (size_t)(t + 2) * kstep;
            const char* a3 = a2 + kstep; const char* b3 = b2 + kstep;
            PG8_LDB(B0, 0, 0); PG8_SCHED; PG8_LDA(At, 0, 0); PG8_STAGE(PG8_SA(1, 1), a1 + hstep, voffA);
            PG8_WAIT_L(8); PG8_BAR; PG8_WAIT_L(0); PG8_MMA(0, 0, At, B0); PG8_BAR; PG8_SCHED;
            PG8_LDB(B1, 0, 1); PG8_STAGE(PG8_SB(0, 0), b2, voffB);
            PG8_BAR; PG8_WAIT_L(0); PG8_MMA(0, 1, At, B1); PG8_BAR;
            PG8_LDA(At, 0, 1); PG8_STAGE(PG8_SA(0, 0), a2, voffA);
            PG8_BAR; PG8_WAIT_L(0); PG8_MMA(1, 0, At, B0); PG8_BAR; PG8_SCHED;
            PG8_STAGE(PG8_SB(0, 1), b2 + hstep, voffB);
            PG8_WAIT_V(6); PG8_BAR; PG8_MMA(1, 1, At, B1); PG8_BAR;
            PG8_LDB(B0, 1, 0); PG8_SCHED; PG8_LDA(At, 1, 0); PG8_STAGE(PG8_SA(0, 1), a2 + hstep, voffA);
            PG8_WAIT_L(8); PG8_BAR; PG8_WAIT_L(0); PG8_MMA(0, 0, At, B0); PG8_BAR; PG8_SCHED;
            PG8_LDB(B1, 1, 1); PG8_STAGE(PG8_SB(1, 0), b3, voffB);
            PG8_BAR; PG8_WAIT_L(0); PG8_MMA(0, 1, At, B1); PG8_BAR;
            PG8_LDA(At, 1, 1); PG8_STAGE(PG8_SA(1, 0), a3, voffA);
            PG8_BAR; PG8_WAIT_L(0); PG8_MMA(1, 0, At, B0); PG8_BAR; PG8_SCHED;
            PG8_STAGE(PG8_SB(1, 1), b3 + hstep, voffB);
            PG8_WAIT_V(6); PG8_BAR; PG8_MMA(1, 1, At, B1); PG8_BAR;
        }
        E(acc, cur, wr, wc, fr, fq);
        if (!has_next) break;
#pragma unroll
        for (int a = 0; a < 2; ++a)
#pragma unroll
            for (int b = 0; b < 2; ++b)
#pragma unroll
                for (int m = 0; m < 4; ++m)
#pragma unroll
                    for (int n = 0; n < 2; ++n) acc[a][b][m][n] = (f32x4){0.f, 0.f, 0.f, 0.f};
        cur = nxt; cA = nA; cB = nB; ++ui;
    }
    PG8_WAIT_V(0);
    if (wr == 0) PG8_BAR;
    PG8_BAR;
#undef PG8_SA
#undef PG8_SB
#undef PG8_STAGE
#undef PG8_LDA
#undef PG8_LDB
#undef PG8_MMA
#undef PG8_WAIT_V
#undef PG8_WAIT_L
#undef PG8_BAR
#undef PG8_SCHED
}
template <class Epi>
DI void gemm_phase4(LAS unsigned char* lds, const Gemm g, const StaticOrder& S, const Epi& E) {
    const int tid = tid_(), wid = __builtin_amdgcn_readfirstlane(tid >> 6), lane = tid & 63, wr = wid >> 2, wc = wid & 3, fr = lane & 15, fq = lane >> 4;
    const int K = g.K, nt = K / BK;
    unsigned voffA[2], voffB[2];
#pragma unroll
    for (int i = 0; i < 2; ++i) { int R, C; stage_rc(tid * 16 + i * 8192, R, C); const int Rb = Epi::PERM ? ((R & ~31) + perm32(R & 31)) : R;
        voffA[i] = (unsigned)(R * K + C) * 2u; voffB[i] = (unsigned)(Rb * K + C) * 2u; }
    const size_t kstep = (size_t)(BK * 2);
    const size_t hstep = (size_t)HALF * K * 2;
    const size_t tstep = 2 * hstep;
    const unsigned ldsw = (unsigned)wid * 1024u;
    const int aoff = lds_byte(wr * 64 + fr, fq * 8), boff = lds_byte(wc * 32 + fr, fq * 8);
#define PG8_SA(b, h) (((b) * 2 + (h)) * HTB)
#define PG8_SB(b, h) ((4 + (b) * 2 + (h)) * HTB)
#define PG8_STAGE(bufoff, gbase, voff) do { _Pragma("unroll") for (int _i = 0; _i < 2; ++_i) \
        __builtin_amdgcn_global_load_lds((const unsigned*)((const char*)(gbase) + (voff)[_i]), (LAS unsigned*)(lds + (bufoff) + ldsw + _i * 8192), 16, 0, 0); } while (0)
#define PG8_LDA(dst, b, h) do { _Pragma("unroll") for (int m = 0; m < 4; ++m) _Pragma("unroll") for (int k = 0; k < 2; ++k) dst[m][k] = *(const LAS bf16x8*)(lds + PG8_SA(b, h) + aoff + m * 2048 + k * 1024); } while (0)
#define PG8_LDB(dst, b, h) do { _Pragma("unroll") for (int n = 0; n < 2; ++n) _Pragma("unroll") for (int k = 0; k < 2; ++k) dst[n][k] = *(const LAS bf16x8*)(lds + PG8_SB(b, h) + boff + n * 2048 + k * 1024); } while (0)
#define PG8_MMA(ai, bj, At, Bt) do { __builtin_amdgcn_s_setprio(1); _Pragma("unroll") for (int m = 0; m < 4; ++m) _Pragma("unroll") for (int n = 0; n < 2; ++n) _Pragma("unroll") for (int k = 0; k < 2; ++k) \
        acc[ai][bj][m][n] = __builtin_amdgcn_mfma_f32_16x16x32_bf16(Bt[n][k], At[m][k], acc[ai][bj][m][n], 0, 0, 0); __builtin_amdgcn_s_setprio(0); } while (0)
#define PG8_WAIT_V(n) asm volatile("s_waitcnt vmcnt(" #n ")" ::: "memory")
#define PG8_WAIT_L(n) asm volatile("s_waitcnt lgkmcnt(" #n ")" ::: "memory")
#define PG8_BAR __builtin_amdgcn_s_barrier()
#define PG8_SCHED __builtin_amdgcn_sched_barrier(0)
    Unit cur, nxt; nxt.pm = 0; nxt.pn = 0; nxt.arow = 0; nxt.ord = 0; int ui = 0;
    if (!S.next(0, cur)) return;
    cur.ord = 0;
    f32x4 acc[2][2][4][2];
#pragma unroll
    for (int a = 0; a < 2; ++a)
#pragma unroll
        for (int b = 0; b < 2; ++b)
#pragma unroll
            for (int m = 0; m < 4; ++m)
#pragma unroll
                for (int n = 0; n < 2; ++n) acc[a][b][m][n] = (f32x4){0.f, 0.f, 0.f, 0.f};
    bf16x8 At[4][2], B0[2][2], B1[2][2];
    const char* cA = (const char*)g.A + (ptrdiff_t)cur.arow * (ptrdiff_t)(K * 2); const char* cB = (const char*)g.Bt + (size_t)cur.pn * tstep;
    PG8_STAGE(PG8_SB(0, 0), cB, voffB); PG8_STAGE(PG8_SA(0, 0), cA, voffA); PG8_STAGE(PG8_SB(0, 1), cB + hstep, voffB); PG8_STAGE(PG8_SA(0, 1), cA + hstep, voffA);
    if (wr == 1) PG8_BAR;
    PG8_WAIT_V(0); PG8_BAR;
    PG8_STAGE(PG8_SB(1, 0), cB + kstep, voffB); PG8_STAGE(PG8_SA(1, 0), cA + kstep, voffA); PG8_STAGE(PG8_SB(1, 1), cB + hstep + kstep, voffB);
    PG8_BAR;
    for (;;) {
        const bool has_next = S.next(ui + 1, nxt); nxt.ord = ui + 1;
        const char* nA = has_next ? (const char*)g.A + (ptrdiff_t)nxt.arow * (ptrdiff_t)(K * 2) : cA; const char* nB = has_next ? (const char*)g.Bt + (size_t)nxt.pn * tstep : cB;
        for (int t = 0; t < nt; t += 2) {
            const bool last = (t == nt - 2);
            const char* a1 = cA + (size_t)(t + 1) * kstep;
            const char* a2 = last ? nA : cA + (size_t)(t + 2) * kstep; const char* b2 = last ? nB : cB + (size_t)(t + 2) * kstep;
            const char* a3 = a2 + kstep; const char* b3 = b2 + kstep;
            PG8_LDB(B0, 0, 0); PG8_LDB(B1, 0, 1); PG8_LDA(At, 0, 0); PG8_STAGE(PG8_SA(1, 1), a1 + hstep, voffA);
            PG8_WAIT_V(8); PG8_WAIT_L(0); PG8_BAR; PG8_MMA(0, 0, At, B0); PG8_MMA(0, 1, At, B1); PG8_BAR; PG8_SCHED;
            PG8_LDA(At, 0, 1); PG8_STAGE(PG8_SB(0, 0), b2, voffB); PG8_STAGE(PG8_SA(0, 0), a2, voffA); PG8_STAGE(PG8_SB(0, 1), b2 + hstep, voffB);
            PG8_WAIT_V(8); PG8_WAIT_L(0); PG8_BAR; PG8_MMA(1, 0, At, B0); PG8_MMA(1, 1, At, B1); PG8_BAR; PG8_SCHED;
            PG8_LDB(B0, 1, 0); PG8_LDB(B1, 1, 1); PG8_LDA(At, 1, 0); PG8_STAGE(PG8_SA(0, 1), a2 + hstep, voffA);
            PG8_WAIT_V(8); PG8_WAIT_L(0); PG8_BAR; PG8_MMA(0, 0, At, B0); PG8_MMA(0, 1, At, B1); PG8_BAR; PG8_SCHED;
            PG8_LDA(At, 1, 1); PG8_STAGE(PG8_SB(1, 0), b3, voffB); PG8_STAGE(PG8_SA(1, 0), a3, voffA); PG8_STAGE(PG8_SB(1, 1), b3 + hstep, voffB);
            PG8_WAIT_V(8); PG8_WAIT_L(0); PG8_BAR; PG8_MMA(1, 0, At, B0); PG8_MMA(1, 1, At, B1); PG8_BAR; PG8_SCHED;
        }
        E(acc, cur, wr, wc, fr, fq);
        if (!has_next) break;
#pragma unroll
        for (int a = 0; a < 2; ++a)
#pragma unroll
            for (int b = 0; b < 2; ++b)
#pragma unroll
                for (int m = 0; m < 4; ++m)
#pragma unroll
                    for (int n = 0; n < 2; ++n) acc[a][b][m][n] = (f32x4){0.f, 0.f, 0.f, 0.f};
        cur = nxt; cA = nA; cB = nB; ++ui;
    }
    PG8_WAIT_V(0);
    if (wr == 0) PG8_BAR;
    PG8_BAR;
#undef PG8_SA
#undef PG8_SB
#undef PG8_STAGE
#undef PG8_LDA
#undef PG8_LDB
#undef PG8_MMA
#undef PG8_WAIT_V
#undef PG8_WAIT_L
#undef PG8_BAR
#undef PG8_SCHED
}
}

DI float ssq_rs(const float* ssq, size_t row) {
    const f32x4* q = (const f32x4*)(ssq + row * 16);
    const f32x4 a = q[0], b = q[1], c = q[2], d = q[3];
    const float s = (((a[0] + a[1]) + (a[2] + a[3])) + ((b[0] + b[1]) + (b[2] + b[3]))) + (((c[0] + c[1]) + (c[2] + c[3])) + ((d[0] + d[1]) + (d[2] + d[3])));
    return rsqrtf(s * (1.0f / 1024.0f) + 1e-6f);
}

constexpr int RST_OFF = 131072 + 4096, RST_MAXU = 23;
DI void build_rstab(LAS unsigned char* lds, const pg8::StaticOrder& S, const float* ssq, int row_max) {
    LAS float* RST = (LAS float*)(lds + RST_OFF);
    const int tid = tid_(), r = tid & 255, par = tid >> 8;
    for (int i = par; i < RST_MAXU; i += 2) { pg8::Unit u; if (!S.next(i, u)) break;
        int grow = u.arow + r; grow = grow < 0 ? 0 : (grow > row_max ? row_max : grow);
        RST[i * 256 + r] = ssq_rs(ssq, (size_t)grow); }
    __syncthreads();
}
struct EpiScale {
    static constexpr bool PERM = true;
    bf16_t* O; int ldc; const LAS float* RST;
    DI void operator()(const f32x4 (&acc)[2][2][4][2], const pg8::Unit& u, int wr, int wc, int fr, int fq) const {
        const int row0 = u.pm * 256 + wr * 64 + fr, col0 = u.pn * 256 + wc * 32 + 8 * fq;
        const int tsel = u.pn >> 1; const int actsel = (tsel == 0) ? 1 : ((tsel == 2 || tsel == 5) ? 2 : 0);
#pragma unroll
        for (int ai = 0; ai < 2; ++ai)
#pragma unroll
            for (int m = 0; m < 4; ++m) {
                const size_t row = (size_t)(row0 + ai * 128 + m * 16); const float rs = RST[u.ord * 256 + wr * 64 + fr + ai * 128 + m * 16];
                bf16_t* rowp = O + row * ldc + col0;
#pragma unroll
                for (int bj = 0; bj < 2; ++bj) { f32x4 v0 = acc[ai][bj][m][0] * rs, v1 = acc[ai][bj][m][1] * rs;
                    if (actsel == 1) {
#pragma unroll
                        for (int j = 0; j < 4; ++j) { v0[j] = geluf_(v0[j]); v1[j] = geluf_(v1[j]); } }
                    else if (actsel == 2) {
#pragma unroll
                        for (int j = 0; j < 4; ++j) { v0[j] = siluf_(v0[j]); v1[j] = siluf_(v1[j]); } }
                    u32x4 w; w.x = cvt_pk_bf16(v0[0], v0[1]); w.y = cvt_pk_bf16(v0[2], v0[3]); w.z = cvt_pk_bf16(v1[0], v1[1]); w.w = cvt_pk_bf16(v1[2], v1[3]);
                    *(u32x4*)(rowp + bj * 128) = w; }
            }
    }
};
struct EpiGelu {
    static constexpr bool PERM = true;
    bf16_t* O; int ldc; const LAS float* RST; const float* bias; float* vst;
    DI void operator()(const f32x4 (&acc)[2][2][4][2], const pg8::Unit& u, int wr, int wc, int fr, int fq) const {
        const int row0 = u.pm * 256 + wr * 64 + fr, col0 = u.pn * 256 + wc * 32 + 8 * fq;
        f32x4 bv[2][2];
#pragma unroll
        for (int bj = 0; bj < 2; ++bj)
#pragma unroll
            for (int n = 0; n < 2; ++n) bv[bj][n] = *(const f32x4*)(bias + col0 + bj * 128 + 4 * n);
#pragma unroll
        for (int ai = 0; ai < 2; ++ai)
#pragma unroll
            for (int m = 0; m < 4; ++m) {
                const size_t row = (size_t)(row0 + ai * 128 + m * 16); const float rs = RST[u.ord * 256 + wr * 64 + fr + ai * 128 + m * 16];
                bf16_t* rowp = O + row * ldc + col0; float s1 = 0.f, s2 = 0.f;
#pragma unroll
                for (int bj = 0; bj < 2; ++bj) { f32x4 v0 = acc[ai][bj][m][0] * rs + bv[bj][0], v1 = acc[ai][bj][m][1] * rs + bv[bj][1];
#pragma unroll
                    for (int j = 0; j < 4; ++j) { v0[j] = geluf_(v0[j]); v1[j] = geluf_(v1[j]); s1 += v0[j] + v1[j]; s2 += v0[j] * v0[j] + v1[j] * v1[j]; }
                    u32x4 w; w.x = cvt_pk_bf16(v0[0], v0[1]); w.y = cvt_pk_bf16(v0[2], v0[3]); w.z = cvt_pk_bf16(v1[0], v1[1]); w.w = cvt_pk_bf16(v1[2], v1[3]);
                    *(u32x4*)(rowp + bj * 128) = w; }
                if (u.pn >= 4) {
                    s1 += __shfl_xor(s1, 16); s1 += __shfl_xor(s1, 32); s2 += __shfl_xor(s2, 16); s2 += __shfl_xor(s2, 32);
                    if (fq == 0) *(f32x2*)(vst + (row * 16 + (size_t)((u.pn - 4) * 4 + wc)) * 2) = (f32x2){s1, s2};
                }
            }
    }
};
struct EpiRes {
    static constexpr bool PERM = false;
    bf16_t* hb; float* ssq;
    DI void operator()(const f32x4 (&acc)[2][2][4][2], const pg8::Unit& u, int wr, int wc, int fr, int fq) const {
        const int row0 = u.pm * 256 + wr * 64 + fr, col0 = u.pn * 256 + wc * 32 + 4 * fq;
#pragma unroll
        for (int ai = 0; ai < 2; ++ai) {
            u32x2 rr[4][2][2];
#pragma unroll
            for (int m = 0; m < 4; ++m) { const size_t off = (size_t)(row0 + ai * 128 + m * 16) * DM + col0;
#pragma unroll
                for (int bj = 0; bj < 2; ++bj)
#pragma unroll
                    for (int n = 0; n < 2; ++n) rr[m][bj][n] = *(const u32x2*)(hb + off + bj * 128 + n * 16); }
#pragma unroll
            for (int m = 0; m < 4; ++m) { const size_t row = (size_t)(row0 + ai * 128 + m * 16); const size_t off = row * DM + col0; float sq = 0.f;
#pragma unroll
                for (int bj = 0; bj < 2; ++bj)
#pragma unroll
                    for (int n = 0; n < 2; ++n) {
                        const u32x2 r = rr[m][bj][n]; const f32x4 v = acc[ai][bj][m][n] + (f32x4){bflo(r.x), bfhi(r.x), bflo(r.y), bfhi(r.y)};
                        u32x2 w; w.x = cvt_pk_bf16(v[0], v[1]); w.y = cvt_pk_bf16(v[2], v[3]); *(u32x2*)(hb + off + bj * 128 + n * 16) = w;
                        sq += (v[0] * v[0] + v[1] * v[1]) + (v[2] * v[2] + v[3] * v[3]);
                    }
                sq += __shfl_xor(sq, 16); sq += __shfl_xor(sq, 32);
                if (fq == 0) ssq[row * 16 + (size_t)(u.pn * 4 + wc)] = sq; }
        }
    }
};

template <int CTRL> DI float dppmov(float oldv, float src) { return __builtin_bit_cast(float, __builtin_amdgcn_update_dpp(__builtin_bit_cast(int, oldv), __builtin_bit_cast(int, src), CTRL, 0xf, 0xf, false)); }
struct EpiFfn {
    static constexpr bool PERM = true;
    bf16_t* act; const LAS float* RST; const float* cw; const float* cb; LAS float* X;
    DI void operator()(f32x4 (&acc)[2][2][4][2], const pg8::Unit& u, int wr, int wc, int fr_, int fq_) const {
        int fr = fr_, fq = fq_; asm volatile("" : "+v"(fr), "+v"(fq));
        const int bb = u.pm / 33, ii = u.pm - bb * 33; const int tok0 = ii * 254 - 2;
        const int chl = wc * 32 + 8 * fq, ch = u.pn * 128 + chl;
#pragma unroll
        for (int ai = 0; ai < 2; ++ai)
#pragma unroll
            for (int m = 0; m < 4; ++m) {
                const int r = 128 * ai + 64 * wr + 16 * m + fr, tok = tok0 + r;
                const float rs = RST[u.ord * 256 + r];
#pragma unroll
                for (int n = 0; n < 2; ++n) { acc[ai][0][m][n] = (tok >= 0) ? acc[ai][0][m][n] * rs : (f32x4){0.f, 0.f, 0.f, 0.f}; acc[ai][1][m][n] = acc[ai][1][m][n] * rs; }
            }
#pragma unroll
        for (int ai = 0; ai < 2; ++ai) { const int slot = ai * 2 + wr;
            if (fr >= 14) {
#pragma unroll
                for (int n = 0; n < 2; ++n) *(LAS f32x4*)(X + ((slot * 2 + (fr - 14)) * 128 + chl + 4 * n)) = acc[ai][0][3][n]; } }
        asm volatile("s_waitcnt lgkmcnt(0)" ::: "memory"); __builtin_amdgcn_s_barrier(); asm volatile("" ::: "memory"); __builtin_amdgcn_s_barrier(); asm volatile("" ::: "memory");
        f32x4 w0[2], w1[2], w2[2], bv[2];
#pragma unroll
        for (int n = 0; n < 2; ++n) { w0[n] = *(const f32x4*)(cw + ch + 4 * n); w1[n] = *(const f32x4*)(cw + DFF + ch + 4 * n); w2[n] = *(const f32x4*)(cw + 2 * DFF + ch + 4 * n); bv[n] = *(const f32x4*)(cb + ch + 4 * n); }
#pragma unroll
        for (int ai = 0; ai < 2; ++ai) {
            const int slot = ai * 2 + wr; f32x4 prev[2];
            { const int rowsel = (fr == 15) ? 1 : 0; const int sl = slot > 0 ? slot - 1 : 0;
#pragma unroll
              for (int n = 0; n < 2; ++n) { prev[n] = *(const LAS f32x4*)(X + ((sl * 2 + rowsel) * 128 + chl + 4 * n)); if (slot == 0) prev[n] = (f32x4){0.f, 0.f, 0.f, 0.f}; } }
#pragma unroll
            for (int m = 0; m < 4; ++m) {
                const int r = 128 * ai + 64 * wr + 16 * m + fr, tok = tok0 + r; float o[8];
#pragma unroll
                for (int n = 0; n < 2; ++n)
#pragma unroll
                    for (int j = 0; j < 4; ++j) { const float g0 = acc[ai][0][m][n][j], p = prev[n][j];
                        const float rot1 = dppmov<0x121>(p, p), rot2 = dppmov<0x122>(p, p);
                        const float g1 = dppmov<0x111>(rot1, g0), g2 = dppmov<0x112>(rot2, g0);
                        const float cv = bv[n][j] + w0[n][j] * g2 + w1[n][j] * g1 + w2[n][j] * g0;
                        o[n * 4 + j] = siluf_(cv) * acc[ai][1][m][n][j]; }
                u32x4 ow; ow.x = cvt_pk_bf16(o[0], o[1]); ow.y = cvt_pk_bf16(o[2], o[3]); ow.z = cvt_pk_bf16(o[4], o[5]); ow.w = cvt_pk_bf16(o[6], o[7]);
                if (r >= 2 && tok < TSEQ) *(u32x4*)(act + (size_t)(bb * 8192 + tok) * DFF + ch) = ow;
                prev[0] = acc[ai][0][m][0]; prev[1] = acc[ai][0][m][1];
            }
        }
    }
};

template <class Epi> DI void run_gemm_ffn(LAS unsigned char* lds, int vc, const bf16_t* A, const bf16_t* Bt, const float* ssq, const Epi& E) {
    pg8::Gemm g{A, Bt, MTOK, 5632, 1024}; pg8::StaticOrder S; S.init_ffn((int)gridDim.x, vc);
    build_rstab(lds, S, ssq, MTOK - 1);
    pg8::gemm_phase4<Epi>(lds, g, S, E);
}
template <class Epi, bool P4 = true> DI void run_gemm(LAS unsigned char* lds, int vc, const bf16_t* A, const bf16_t* Bt, int Mrows, int N, int K, const Epi& E, const float* ssq = nullptr) {
    pg8::Gemm g{A, Bt, Mrows, N, K}; pg8::StaticOrder S; S.init(Mrows, N, (int)gridDim.x, vc);
    if (ssq) build_rstab(lds, S, ssq, Mrows - 1);
    if (P4) pg8::gemm_phase4<Epi>(lds, g, S, E); else pg8::gemm_phase<Epi>(lds, g, S, E);
}

DI void transpose_item(const float* W, int K, int N, bf16_t* WT, const float* gain, LAS float* scr, int item, int lane, bool ffn_remap = false) {
    const int nblk = N / 32, kb = item / nblk, nb = item % nblk, k0 = 64 * kb, n0 = 32 * nb;
    const int r0 = ffn_remap ? ((n0 < DFF) ? (n0 / 128) * 256 + (n0 % 128) : ((n0 - DFF) / 128) * 256 + 128 + ((n0 - DFF) % 128)) : n0;
#pragma unroll 8
    for (int i = 0; i < 32; ++i) { const int kk = 2 * i + (lane >> 5); float v = W[(size_t)(k0 + kk) * N + n0 + (lane & 31)]; if (gain) v *= gain[k0 + kk]; scr[kk * 33 + (lane & 31)] = v; }
    asm volatile("s_waitcnt lgkmcnt(0)" ::: "memory");
    const int c = lane & 7;
#pragma unroll
    for (int j = 0; j < 4; ++j) { const int n = (lane >> 3) + 8 * j; const LAS float* s = scr + (8 * c) * 33 + n;
        u32x4 o; o.x = cvt_pk_bf16(s[0 * 33], s[1 * 33]); o.y = cvt_pk_bf16(s[2 * 33], s[3 * 33]); o.z = cvt_pk_bf16(s[4 * 33], s[5 * 33]); o.w = cvt_pk_bf16(s[6 * 33], s[7 * 33]);
        *(u32x4*)(WT + (size_t)(r0 + n) * K + k0 + 8 * c) = o; }
    asm volatile("s_waitcnt lgkmcnt(0)" ::: "memory");
}
DI void phase_prep(LAS unsigned char* lds, const Args& a) {
    const int tid = tid_(), lane = tid & 63, wave = tid >> 6;
    const int gw = bid_() * 8 + wave, NGW = (int)gridDim.x * 8;
    unsigned char* ws = a.ws;
    LAS float* scr = (LAS float*)(lds + wave * 8448);
    constexpr int I_IN0 = 16 * 96, I_OUT = 16 * 32, I_UP = 16 * 176, I_DN = 44 * 32, I_IN1 = 16 * 64;
    constexpr int NITEMS = I_IN0 + I_OUT + I_UP + I_DN + I_IN1 + I_OUT + I_UP + I_DN;
    for (int it = gw; it < NITEMS; it += NGW) {
        int r = it;
        if (r < I_IN0) { transpose_item(a.in[4], 1024, 3072, (bf16_t*)(ws + WS_WIN0), a.in[1], scr, r, lane); continue; } r -= I_IN0;
        if (r < I_OUT) { transpose_item(a.in[14], 1024, 1024, (bf16_t*)(ws + WS_WOUT0), nullptr, scr, r, lane); continue; } r -= I_OUT;
        if (r < I_UP) { transpose_item(a.in[22], 1024, 5632, (bf16_t*)(ws + WS_WUP0), a.in[2], scr, r, lane, true); continue; } r -= I_UP;
        if (r < I_DN) { transpose_item(a.in[25], 2816, 1024, (bf16_t*)(ws + WS_WDN0), nullptr, scr, r, lane); continue; } r -= I_DN;
        if (r < I_IN1) { transpose_item(a.in[15], 1024, 2048, (bf16_t*)(ws + WS_WIN1), a.in[1] + 1024, scr, r, lane); continue; } r -= I_IN1;
        if (r < I_OUT) { transpose_item(a.in[21], 1024, 1024, (bf16_t*)(ws + WS_WOUT1), nullptr, scr, r, lane); continue; } r -= I_OUT;
        if (r < I_UP) { transpose_item(a.in[22] + (size_t)1024 * 5632, 1024, 5632, (bf16_t*)(ws + WS_WUP1), a.in[2] + 1024, scr, r, lane, true); continue; } r -= I_UP;
        transpose_item(a.in[25] + (size_t)2816 * 1024, 2816, 1024, (bf16_t*)(ws + WS_WDN1), nullptr, scr, r, lane);
    }
    { const float* w_s = a.in[19]; bf16_t* wsc = (bf16_t*)(ws + WS_WSC);
      for (int i = bid_() * NTHR + tid; i < 8 * 128 * 128; i += (int)gridDim.x * NTHR) { const int t = (i >> 7) & 127, s = i & 127; wsc[i] = (s <= t) ? f2bf(w_s[i]) : (bf16_t)0; } }
    { const float* x = a.in[0]; bf16_t* xb = (bf16_t*)(ws + WS_HB); float* ssq = (float*)(ws + WS_SSQ);
      for (int m = gw; m < MTOK; m += NGW) {
          const f32x4* xr = (const f32x4*)(x + (size_t)m * DM) + lane; f32x4 v[4]; float s = 0.f;
#pragma unroll
          for (int j = 0; j < 4; ++j) { v[j] = xr[64 * j]; s += (v[j][0] * v[j][0] + v[j][1] * v[j][1]) + (v[j][2] * v[j][2] + v[j][3] * v[j][3]); }
          s = wave_sum(s);
          u32x2* o8 = (u32x2*)(xb + (size_t)m * DM) + lane;
#pragma unroll
          for (int j = 0; j < 4; ++j) { u32x2 w; w.x = cvt_pk_bf16(v[j][0], v[j][1]); w.y = cvt_pk_bf16(v[j][2], v[j][3]); o8[64 * j] = w; }
          if (lane < 16) ssq[(size_t)m * 16 + lane] = (lane == 0) ? s : 0.f;
      } }
}

template <bool FINAL>
DI void lru_item(LAS unsigned char* lds, const Args& a, int it) {
    const int tid = tid_(), lane = tid & 63, w = tid >> 6;
    const int b = it >> 5, cb = (it >> 2) & 7, seg = it & 3;
    const bf16_t* z = (const bf16_t*)(a.ws + WS_Z); bf16_t* mix = (bf16_t*)(a.ws + WS_MIX); float* agg = (float*)(a.ws + WS_LRUAGG);
    LAS bf16_t* WaT = (LAS bf16_t*)lds;
    LAS bf16_t* WxT = WaT + 64 * 72;
    LAS bf16_t* XR = WxT + 64 * 72;
    LAS bf16_t* XC = XR + 132 * 64;
    LAS float* AA = (LAS float*)(XC + 128 * 72);
    LAS float* UU = AA + 128 * 64;
    LAS float* SPp = UU + 128 * 64;
    LAS float* SHh = SPp + 512;
    LAS float* TAB = SHh + 512;
    LAS bf16_t* YT = (LAS bf16_t*)(TAB + 512);
    static_assert((64 * 72 * 2 + 132 * 64 + 128 * 72) * 2 + (128 * 64 * 2 + 512 * 3) * 4 + 128 * 64 * 2 <= 158720, "lru lds");
    { const float* wa = a.in[7] + cb * 4096; const float* wx = a.in[9] + cb * 4096;
#pragma unroll
      for (int r = 0; r < 8; ++r) { const int e = tid + 512 * r, i = e >> 6, j = e & 63; WaT[j * 72 + i] = f2bf(wa[e]); WxT[j * 72 + i] = f2bf(wx[e]); }
      if (tid < 64) { const int ch = cb * 64 + tid;
#pragma unroll
          for (int k = 0; k < 4; ++k) TAB[k * 64 + tid] = a.in[5][k * 512 + ch];
          TAB[256 + tid] = a.in[6][ch]; TAB[320 + tid] = a.in[8][ch]; TAB[384 + tid] = a.in[10][ch]; TAB[448 + tid] = log1pf(expf(-a.in[11][ch])); } }
    const int c = tid & 63, sub = tid >> 6;
    float h = 0.f, Ptot = 1.f;
    if (FINAL) for (int j = 0; j < seg; ++j) { const f32x2 pq = *(const f32x2*)(agg + ((size_t)((b * 4 + j) * 512 + cb * 64 + c)) * 2); h = pq[0] * h + pq[1]; }
    const bf16_t* zb = z + (size_t)b * TSEQ * 3072 + cb * 64 + (tid & 7) * 8;
    const int prow = tid >> 3;
    u32x4 pfx[3], pfy[2];
    { const int t0 = seg * 2048;
#pragma unroll
      for (int k = 0; k < 3; ++k) { const int r = prow + 64 * k, tok = t0 - 3 + r; u32x4 v = (u32x4){0u, 0u, 0u, 0u};
          if (r < 131 && tok >= 0) v = *(const u32x4*)(zb + (size_t)tok * 3072 + 512);
          if (r < 131) *(LAS u32x4*)(XR + r * 64 + (tid & 7) * 8) = v; }
      if (FINAL) {
#pragma unroll
          for (int k = 0; k < 2; ++k) pfy[k] = *(const u32x4*)(zb + (size_t)(t0 + prow + 64 * k) * 3072); } }
    __syncthreads();
    const float cw0 = TAB[c], cw1 = TAB[64 + c], cw2 = TAB[128 + c], cw3 = TAB[192 + c], cbv = TAB[256 + c];
    for (int tile = 0; tile < 16; ++tile) {
        const int t0 = seg * 2048 + tile * 128; const bool more = tile + 1 < 16;
        if (more) {
#pragma unroll
            for (int k = 0; k < 3; ++k) { const int r = prow + 64 * k; if (r < 131) pfx[k] = *(const u32x4*)(zb + (size_t)(t0 + 128 - 3 + r) * 3072 + 512); }
        }
#pragma unroll
        for (int i = 0; i < 16; ++i) { const int t = sub + 8 * i;
            const float xc = cbv + cw0 * bf2f(XR[t * 64 + c]) + cw1 * bf2f(XR[(t + 1) * 64 + c]) + cw2 * bf2f(XR[(t + 2) * 64 + c]) + cw3 * bf2f(XR[(t + 3) * 64 + c]);
            XC[t * 72 + c] = f2bf(xc); }
        __syncthreads();
        if (FINAL) {
#pragma unroll
            for (int k = 0; k < 2; ++k) *(LAS u32x4*)(YT + (prow + 64 * k) * 64 + (tid & 7) * 8) = pfy[k];
            if (more) {
#pragma unroll
                for (int k = 0; k < 2; ++k) pfy[k] = *(const u32x4*)(zb + (size_t)(t0 + 128 + prow + 64 * k) * 3072); }
        }
        {
            f32x4 accA[4], accX[4];
#pragma unroll
            for (int nt = 0; nt < 4; ++nt) { accA[nt] = (f32x4){0.f, 0.f, 0.f, 0.f}; accX[nt] = (f32x4){0.f, 0.f, 0.f, 0.f}; }
#pragma unroll
            for (int k = 0; k < 2; ++k) { const bf16x8 av = *(const LAS bf16x8*)(XC + (w * 16 + (lane & 15)) * 72 + k * 32 + 8 * (lane >> 4));
#pragma unroll
                for (int nt = 0; nt < 4; ++nt) { const bf16x8 ba = *(const LAS bf16x8*)(WaT + (nt * 16 + (lane & 15)) * 72 + k * 32 + 8 * (lane >> 4)), bx = *(const LAS bf16x8*)(WxT + (nt * 16 + (lane & 15)) * 72 + k * 32 + 8 * (lane >> 4));
                    accA[nt] = __builtin_amdgcn_mfma_f32_16x16x32_bf16(av, ba, accA[nt], 0, 0, 0); accX[nt] = __builtin_amdgcn_mfma_f32_16x16x32_bf16(av, bx, accX[nt], 0, 0, 0); } }
#pragma unroll
            for (int nt = 0; nt < 4; ++nt) { const int cc = nt * 16 + (lane & 15);
                const float k0 = TAB[cc], k1 = TAB[64 + cc], k2 = TAB[128 + cc], k3 = TAB[192 + cc], kb = TAB[256 + cc], ba = TAB[320 + cc], bx = TAB[384 + cc], spl = TAB[448 + cc];
#pragma unroll
                for (int j = 0; j < 4; ++j) { const int t = w * 16 + 4 * (lane >> 4) + j;
                    const float r = sigmoidf_(accA[nt][j] + ba), ig = sigmoidf_(accX[nt][j] + bx);
                    const float av = __expf(-8.0f * r * spl);
                    const float xc = kb + k0 * bf2f(XR[t * 64 + cc]) + k1 * bf2f(XR[(t + 1) * 64 + cc]) + k2 * bf2f(XR[(t + 2) * 64 + cc]) + k3 * bf2f(XR[(t + 3) * 64 + cc]);
                    AA[t * 64 + cc] = av; UU[t * 64 + cc] = __builtin_amdgcn_sqrtf(fmaxf(1.0f - av * av, 0.f)) * (ig * xc); }
            }
        }
        __syncthreads();
        if (more) {
#pragma unroll
            for (int k = 0; k < 3; ++k) { const int r = prow + 64 * k; if (r < 131) *(LAS u32x4*)(XR + r * 64 + (tid & 7) * 8) = pfx[k]; }
        }
        { float P = 1.f, Hh = 0.f;
#pragma unroll
          for (int i = 0; i < 16; ++i) { const int t = sub * 16 + i; const float a_ = AA[t * 64 + c], u_ = UU[t * 64 + c]; Hh = a_ * Hh + u_; P *= a_; }
          SPp[sub * 64 + c] = P; SHh[sub * 64 + c] = Hh; }
        __syncthreads();
        float hin = h;
#pragma unroll
        for (int s = 0; s < 8; ++s) { const float p = SPp[s * 64 + c], q = SHh[s * 64 + c]; if (s < sub) hin = p * hin + q; h = p * h + q; Ptot *= p; }
        if (FINAL) {
            float hh = hin;
#pragma unroll
            for (int i = 0; i < 16; ++i) { const int t = sub * 16 + i;
                hh = AA[t * 64 + c] * hh + UU[t * 64 + c];
                const float y = bf2f(YT[t * 64 + c]);
                YT[t * 64 + c] = f2bf(y * hh); }
            __syncthreads();
#pragma unroll
            for (int k = 0; k < 2; ++k) { const int r = prow + 64 * k;
                *(u32x4*)(mix + ((size_t)b * TSEQ + t0 + r) * 1024 + cb * 64 + (tid & 7) * 8) = *(const LAS u32x4*)(YT + r * 64 + (tid & 7) * 8); }
        }
    }
    if (!FINAL && sub == 0) *(f32x2*)(agg + ((size_t)((b * 4 + seg) * 512 + cb * 64 + c)) * 2) = (f32x2){Ptot, h};
    __syncthreads();
}

template <bool FINAL>
DI void hgrn_item(LAS unsigned char* lds, const Args& a, int it) {
    const int tid = tid_(), lane = tid & 63, w = tid >> 6, l15 = lane & 15, q4 = lane >> 4;
    const int bh = it >> 3, seg = it & 7, b = bh >> 2, hd = bh & 3;
    const bf16_t* z = (const bf16_t*)(a.ws + WS_Z); bf16_t* mix = (bf16_t*)(a.ws + WS_MIX);
    float* HGS = (float*)(a.ws + WS_HGS); float* HGD = (float*)(a.ws + WS_HGD);
    LAS bf16_t* QS = (LAS bf16_t*)lds;
    LAS bf16_t* KS = QS + 64 * 136;
    LAS bf16_t* KSt = KS + 64 * 136;
    LAS bf16_t* Vt = KSt + 128 * 72;
    LAS bf16_t* Pm = Vt + 128 * 72;
    LAS bf16_t* St = Pm + 64 * 72;
    LAS float* CS = (LAS float*)(St + 128 * 136);
    LAS float* EM = CS + 512; LAS float* EL = EM + 128; LAS float* DEC = EL + 128; LAS float* GN = DEC + 128;
    LAS bf16_t* RV = (LAS bf16_t*)(GN + 128);
    LAS bf16_t* RF = Pm;
    LAS bf16_t* RQ = RF + 64 * 128;
    LAS float* OB = (LAS float*)lds;
    static_assert((64 * 136 * 2 + 128 * 72 * 2 + 64 * 72 + 128 * 136) * 2 + (512 + 128 * 4) * 4 + 64 * 128 * 2 <= 158720, "hgrn lds");
    static_assert(64 * 132 * 4 <= 64 * 136 * 2 * 2 && 2 * 64 * 128 <= 64 * 72 + 128 * 136, "hgrn aliases");
    const int dk = tid & 127, sub = tid >> 7;
    float lbv;
    { const float* lg = a.in[12]; const int col = hd * 128 + dk; const float l0 = lg[col], l1 = lg[512 + col], l2 = lg[1024 + col];
      const float mx = fmaxf(l0, fmaxf(l1, l2)); const float e0 = __expf(l0 - mx), e1 = __expf(l1 - mx), e2 = __expf(l2 - mx); lbv = e0 / (e0 + e1 + e2); }
    if (tid < 128) GN[tid] = a.in[13][tid];
    f32x4 Sacc[8];
#pragma unroll
    for (int nt = 0; nt < 8; ++nt) Sacc[nt] = (f32x4){0.f, 0.f, 0.f, 0.f};
    if (FINAL) for (int j = 0; j < seg; ++j) { const int itj = bh * 8 + j;
#pragma unroll
        for (int nt = 0; nt < 8; ++nt) { const float d = HGD[(size_t)itj * 128 + nt * 16 + l15];
            const f32x4 sj = *(const f32x4*)(HGS + (size_t)itj * 16384 + (size_t)((w * 8 + nt) * 64 + lane) * 4); Sacc[nt] = Sacc[nt] * d + sj; } }
    float dtot = 1.f;
    const size_t tok0 = (size_t)b * TSEQ + seg * 1024;
    const bf16_t* zbase = z + (tok0 + (tid >> 4)) * 3072 + hd * 128 + (tid & 15) * 8;
    const int roff = (tid >> 4) * 128 + (tid & 15) * 8;
    u32x4 pf_f[2], pf_v[2], pf_q[2];
#pragma unroll
    for (int k = 0; k < 2; ++k) { const bf16_t* p = zbase + (size_t)(32 * k) * 3072; pf_f[k] = *(const u32x4*)(p + 1536); pf_v[k] = *(const u32x4*)(p + 2048); if (FINAL) pf_q[k] = *(const u32x4*)(p + 1024); }
#pragma unroll
    for (int k = 0; k < 2; ++k) { *(LAS u32x4*)(RF + roff + k * 4096) = pf_f[k]; *(LAS u32x4*)(RV + roff + k * 4096) = pf_v[k]; if (FINAL) *(LAS u32x4*)(RQ + roff + k * 4096) = pf_q[k]; }
    __syncthreads();
    for (int ck = 0; ck < 16; ++ck) {
        const size_t rowbase = tok0 + ck * 64;
        const bool more = ck + 1 < 16;
        if (more) {
#pragma unroll
            for (int k = 0; k < 2; ++k) { const bf16_t* p = zbase + (size_t)((ck + 1) * 64 + 32 * k) * 3072; pf_f[k] = *(const u32x4*)(p + 1536); pf_v[k] = *(const u32x4*)(p + 2048); if (FINAL) pf_q[k] = *(const u32x4*)(p + 1024); }
        }
        float pf[16], kf[16];
        { float run = 1.f;
#pragma unroll
          for (int i = 0; i < 16; ++i) { const float fl = bf2f(RF[(sub * 16 + i) * 128 + dk]);
              const float f = lbv + (1.0f - lbv) * sigmoidf_(fl); kf[i] = 1.0f - f; run *= f; pf[i] = run; }
          CS[sub * 128 + dk] = run; }
        __syncthreads();
        {
            const float c0 = CS[dk], c1 = CS[128 + dk], c2 = CS[256 + dk], c3 = CS[384 + dk];
            const float offs = (sub > 0 ? c0 : 1.f) * (sub > 1 ? c1 : 1.f) * (sub > 2 ? c2 : 1.f);
            const float pmid = c0 * c1, plast = pmid * c2 * c3; const float rpmid = __builtin_amdgcn_rcpf(pmid);
#pragma unroll
            for (int i = 0; i < 16; ++i) { const int s = sub * 16 + i; const float P = offs * pf[i];
                const bf16_t ks = f2bf(kf[i] * pmid * __builtin_amdgcn_rcpf(P));
                KSt[dk * 72 + s] = ks; Vt[dk * 72 + s] = RV[s * 128 + dk];
                if (FINAL) { KS[s * 136 + dk] = ks; const float q = bf2f(RQ[s * 128 + dk]); QS[s * 136 + dk] = f2bf(q * (P * rpmid)); } }
            if (sub == 0) { EM[dk] = pmid; EL[dk] = c2 * c3; DEC[dk] = plast; }
            dtot *= plast;
        }
        __syncthreads();
        f32x4 oacc[4];
        if (FINAL) {
#pragma unroll
            for (int nt = 0; nt < 8; ++nt) { const float em = EM[nt * 16 + l15];
#pragma unroll
                for (int j = 0; j < 4; ++j) St[(16 * w + 4 * q4 + j) * 136 + nt * 16 + l15] = f2bf(Sacc[nt][j] * em); }
            { const int mt = w >> 1, n0 = (w & 1) * 2; f32x4 sc0 = (f32x4){0.f, 0.f, 0.f, 0.f}, sc1 = sc0;
#pragma unroll
              for (int k = 0; k < 4; ++k) { const bf16x8 av = *(const LAS bf16x8*)(QS + (mt * 16 + l15) * 136 + k * 32 + 8 * q4);
                  const bf16x8 b0 = *(const LAS bf16x8*)(KS + (n0 * 16 + l15) * 136 + k * 32 + 8 * q4), b1 = *(const LAS bf16x8*)(KS + ((n0 + 1) * 16 + l15) * 136 + k * 32 + 8 * q4);
                  sc0 = __builtin_amdgcn_mfma_f32_16x16x32_bf16(av, b0, sc0, 0, 0, 0); sc1 = __builtin_amdgcn_mfma_f32_16x16x32_bf16(av, b1, sc1, 0, 0, 0); }
#pragma unroll
              for (int j = 0; j < 4; ++j) { const int t = mt * 16 + 4 * q4 + j, s0 = n0 * 16 + l15, s1 = s0 + 16;
                  Pm[t * 72 + s0] = (s0 <= t) ? f2bf(sc0[j]) : (bf16_t)0; Pm[t * 72 + s1] = (s1 <= t) ? f2bf(sc1[j]) : (bf16_t)0; } }
            __syncthreads();
#pragma unroll
            for (int m4 = 0; m4 < 4; ++m4) oacc[m4] = (f32x4){0.f, 0.f, 0.f, 0.f};
#pragma unroll
            for (int k = 0; k < 2; ++k) { const bf16x8 bv = *(const LAS bf16x8*)(Vt + (16 * w + l15) * 72 + k * 32 + 8 * q4);
#pragma unroll
                for (int m4 = 0; m4 < 4; ++m4) { const bf16x8 av = *(const LAS bf16x8*)(Pm + (m4 * 16 + l15) * 72 + k * 32 + 8 * q4); oacc[m4] = __builtin_amdgcn_mfma_f32_16x16x32_bf16(av, bv, oacc[m4], 0, 0, 0); } }
#pragma unroll
            for (int k = 0; k < 4; ++k) { const bf16x8 bv = *(const LAS bf16x8*)(St + (16 * w + l15) * 136 + k * 32 + 8 * q4);
#pragma unroll
                for (int m4 = 0; m4 < 4; ++m4) { const bf16x8 av = *(const LAS bf16x8*)(QS + (m4 * 16 + l15) * 136 + k * 32 + 8 * q4); oacc[m4] = __builtin_amdgcn_mfma_f32_16x16x32_bf16(av, bv, oacc[m4], 0, 0, 0); } }
        } else if (more) {
#pragma unroll
            for (int k = 0; k < 2; ++k) { *(LAS u32x4*)(RF + roff + k * 4096) = pf_f[k]; *(LAS u32x4*)(RV + roff + k * 4096) = pf_v[k]; }
        }
        {
            f32x4 kv[8];
#pragma unroll
            for (int nt = 0; nt < 8; ++nt) kv[nt] = (f32x4){0.f, 0.f, 0.f, 0.f};
#pragma unroll
            for (int k = 0; k < 2; ++k) { const bf16x8 av = *(const LAS bf16x8*)(Vt + (16 * w + l15) * 72 + k * 32 + 8 * q4);
#pragma unroll
                for (int nt = 0; nt < 8; ++nt) { const bf16x8 bv = *(const LAS bf16x8*)(KSt + (nt * 16 + l15) * 72 + k * 32 + 8 * q4); kv[nt] = __builtin_amdgcn_mfma_f32_16x16x32_bf16(av, bv, kv[nt], 0, 0, 0); } }
#pragma unroll
            for (int nt = 0; nt < 8; ++nt) { const float dec = DEC[nt * 16 + l15], el = EL[nt * 16 + l15]; Sacc[nt] = Sacc[nt] * dec + kv[nt] * el; }
        }
        if (FINAL) {
            __syncthreads();
#pragma unroll
            for (int m4 = 0; m4 < 4; ++m4)
#pragma unroll
                for (int j = 0; j < 4; ++j) OB[(m4 * 16 + 4 * q4 + j) * 132 + 16 * w + l15] = oacc[m4][j];
            if (more) {
#pragma unroll
                for (int k = 0; k < 2; ++k) { *(LAS u32x4*)(RF + roff + k * 4096) = pf_f[k]; *(LAS u32x4*)(RV + roff + k * 4096) = pf_v[k]; *(LAS u32x4*)(RQ + roff + k * 4096) = pf_q[k]; }
            }
            __syncthreads();
            const int t = tid >> 3, part = tid & 7; const size_t row = rowbase + t;
            f32x4 o[4]; float ss = 0.f;
#pragma unroll
            for (int i = 0; i < 4; ++i) { o[i] = *(const LAS f32x4*)(OB + t * 132 + part * 16 + i * 4); ss += (o[i][0] * o[i][0] + o[i][1] * o[i][1]) + (o[i][2] * o[i][2] + o[i][3] * o[i][3]); }
            ss += __shfl_xor(ss, 1); ss += __shfl_xor(ss, 2); ss += __shfl_xor(ss, 4);
            const float rstd = rsqrtf(ss * (1.0f / 128.0f) + 1e-6f);
            const u32x4* gp = (const u32x4*)(z + row * 3072 + 2560 + hd * 128 + part * 16); u32x4* op = (u32x4*)(mix + row * 1024 + 512 + hd * 128 + part * 16);
#pragma unroll
            for (int hh = 0; hh < 2; ++hh) { const u32x4 gw = gp[hh]; u32x4 ow;
#pragma unroll
                for (int e = 0; e < 4; ++e) { const unsigned gword = gw[e]; const int i0 = hh * 8 + e * 2;
                    const float v0 = o[i0 >> 2][i0 & 3] * rstd * GN[part * 16 + i0] * bflo(gword);
                    const float v1 = o[(i0 + 1) >> 2][(i0 + 1) & 3] * rstd * GN[part * 16 + i0 + 1] * bfhi(gword);
                    ow[e] = cvt_pk_bf16(v0, v1); }
                op[hh] = ow; }
        } else {
            __syncthreads();
        }
    }
    if (!FINAL) {
#pragma unroll
        for (int nt = 0; nt < 8; ++nt) *(f32x4*)(HGS + (size_t)it * 16384 + (size_t)((w * 8 + nt) * 64 + lane) * 4) = Sacc[nt];
        if (sub == 0) HGD[(size_t)it * 128 + dk] = dtot;
    }
    __syncthreads();
}

template <bool FINAL> DI void phase_mixer0(LAS unsigned char* lds, const Args& a) {
#ifndef NO_HG
    for (int it = bid_(); it < 256; it += (int)gridDim.x) hgrn_item<FINAL>(lds, a, it);
#endif
#ifndef NO_LRU
    for (int it = bid_(); it < 256; it += (int)gridDim.x) lru_item<FINAL>(lds, a, it);
#endif
}

DI void phase_sgu(LAS unsigned char* lds, const Args& a) {
    const int tid = tid_(), lane = tid & 63, w = tid >> 6, c8 = tid & 15;
    const bf16_t* uv = (const bf16_t*)(a.ws + WS_UV); bf16_t* sg = (bf16_t*)(a.ws + WS_SG); const bf16_t* wsc = (const bf16_t*)(a.ws + WS_WSC); const float* vst = (const float*)(a.ws + WS_VST);
    LAS bf16_t* WC = (LAS bf16_t*)lds;
    LAS bf16_t* VnT = WC + 128 * 136;
    LAS float* MU = (LAS float*)(VnT + 128 * 136); LAS float* RS = MU + 128;
    LAS float* OT = (LAS float*)(lds + 70656);
    const int G = (int)gridDim.x;
    int cur_g = -1; float lg[8], lb8[8];
#pragma unroll
    for (int e = 0; e < 8; ++e) { lg[e] = 0.f; lb8[e] = 0.f; }
    u32x4 raw[4]; float mu_r = 0.f, rs_r = 0.f;
    int it = bid_();
    if (it < 4096) { const size_t rb = (size_t)(it >> 3) * 128; const int g = it & 7;
#pragma unroll
        for (int i = 0; i < 4; ++i) raw[i] = *(const u32x4*)(uv + (rb + (tid >> 4) + 32 * i) * 2048 + 1024 + g * 128 + c8 * 8);
        if (tid < 128) { const size_t row = rb + tid; float s1 = 0.f, s2 = 0.f;
#pragma unroll
            for (int p = 0; p < 16; ++p) { const f32x2 q = *(const f32x2*)(vst + (row * 16 + p) * 2); s1 += q[0]; s2 += q[1]; }
            mu_r = s1 * (1.0f / 1024.0f); rs_r = rsqrtf(fmaxf(s2 * (1.0f / 1024.0f) - mu_r * mu_r, 0.f) + 1e-6f); } }
    for (; it < 4096; it += G) {
        const int g = it & 7; const size_t rowbase = (size_t)(it >> 3) * 128;
        if (g != cur_g) { cur_g = g;
#pragma unroll
            for (int r = 0; r < 4; ++r) { const int e = tid + 512 * r, t = e >> 4, ch = e & 15; *(LAS u32x4*)(WC + t * 136 + ch * 8) = *(const u32x4*)(wsc + g * 16384 + t * 128 + ch * 8); }
#pragma unroll
            for (int e = 0; e < 8; ++e) { lg[e] = a.in[17][g * 128 + c8 * 8 + e]; lb8[e] = a.in[18][g * 128 + c8 * 8 + e]; } }
        if (tid < 128) { MU[tid] = mu_r; RS[tid] = rs_r; }
        u32x4 cur[4];
#pragma unroll
        for (int i = 0; i < 4; ++i) cur[i] = raw[i];
        __syncthreads();
        { const int nit = it + G;
          if (nit < 4096) { const size_t rb = (size_t)(nit >> 3) * 128; const int gn = nit & 7;
#pragma unroll
              for (int i = 0; i < 4; ++i) raw[i] = *(const u32x4*)(uv + (rb + (tid >> 4) + 32 * i) * 2048 + 1024 + gn * 128 + c8 * 8);
              if (tid < 128) { const size_t row = rb + tid; float s1 = 0.f, s2 = 0.f;
#pragma unroll
                  for (int p = 0; p < 16; ++p) { const f32x2 q = *(const f32x2*)(vst + (row * 16 + p) * 2); s1 += q[0]; s2 += q[1]; }
                  mu_r = s1 * (1.0f / 1024.0f); rs_r = rsqrtf(fmaxf(s2 * (1.0f / 1024.0f) - mu_r * mu_r, 0.f) + 1e-6f); } } }
        u32x4 uq[4];
#pragma unroll
        for (int i = 0; i < 4; ++i) uq[i] = *(const u32x4*)(uv + (rowbase + 16 * w + (lane >> 4) + 4 * i) * 2048 + g * 128 + (lane & 15) * 8);
#pragma unroll
        for (int i = 0; i < 4; ++i) { const int s = (tid >> 4) + 32 * i; const u32x4 rw = cur[i];
            const float mu = MU[s], rs = RS[s];
#pragma unroll
            for (int e = 0; e < 4; ++e) { const float v0 = (bflo(rw[e]) - mu) * rs * lg[2 * e] + lb8[2 * e], v1 = (bfhi(rw[e]) - mu) * rs * lg[2 * e + 1] + lb8[2 * e + 1];
                VnT[(c8 * 8 + 2 * e) * 136 + s] = f2bf(v0); VnT[(c8 * 8 + 2 * e + 1) * 136 + s] = f2bf(v1); } }
        __syncthreads();
        f32x4 acc[8];
#pragma unroll
        for (int nt = 0; nt < 8; ++nt) acc[nt] = (f32x4){0.f, 0.f, 0.f, 0.f};
#pragma unroll
        for (int k = 0; k < 4; ++k) { const bf16x8 av = *(const LAS bf16x8*)(WC + (16 * w + (lane & 15)) * 136 + k * 32 + 8 * (lane >> 4));
#pragma unroll
            for (int nt = 0; nt < 8; ++nt) { const bf16x8 bv = *(const LAS bf16x8*)(VnT + (nt * 16 + (lane & 15)) * 136 + k * 32 + 8 * (lane >> 4));
                acc[nt] = __builtin_amdgcn_mfma_f32_16x16x32_bf16(av, bv, acc[nt], 0, 0, 0); } }
#pragma unroll
        for (int nt = 0; nt < 8; ++nt)
#pragma unroll
            for (int j = 0; j < 4; ++j) OT[(16 * w + 4 * (lane >> 4) + j) * 132 + nt * 16 + (lane & 15)] = acc[nt][j];
        asm volatile("s_waitcnt lgkmcnt(0)" ::: "memory");
#pragma unroll
        for (int i = 0; i < 4; ++i) { const int tl = 16 * w + (lane >> 4) + 4 * i; const float bias = a.in[20][g * 128 + tl];
            const f32x4 o0 = *(const LAS f32x4*)(OT + tl * 132 + (lane & 15) * 8), o1 = *(const LAS f32x4*)(OT + tl * 132 + (lane & 15) * 8 + 4);
            const u32x4 uu = uq[i]; u32x4 ow;
            ow.x = cvt_pk_bf16(bflo(uu.x) * (o0[0] + bias), bfhi(uu.x) * (o0[1] + bias)); ow.y = cvt_pk_bf16(bflo(uu.y) * (o0[2] + bias), bfhi(uu.y) * (o0[3] + bias));
            ow.z = cvt_pk_bf16(bflo(uu.z) * (o1[0] + bias), bfhi(uu.z) * (o1[1] + bias)); ow.w = cvt_pk_bf16(bflo(uu.w) * (o1[2] + bias), bfhi(uu.w) * (o1[3] + bias));
            *(u32x4*)(sg + (rowbase + tl) * 1024 + g * 128 + (lane & 15) * 8) = ow; }
        __syncthreads();
    }
}

DI void phase_final(const Args& a) {
    const int tid = tid_(), lane = tid & 63, wave = tid >> 6;
    const int gw = bid_() * 8 + wave, NGW = (int)gridDim.x * 8;
    const float* ssq = (const float*)(a.ws + WS_SSQ); const float* gn = a.in[3]; const bf16_t* hb = (const bf16_t*)(a.ws + WS_HB);
    f32x4 gv[4];
#pragma unroll
    for (int j = 0; j < 4; ++j) gv[j] = *((const f32x4*)gn + lane + 64 * j);
    for (int m = gw; m < MTOK; m += NGW) {
        const float rs = ssq_rs(ssq, (size_t)m);
        const u32x2* hp = (const u32x2*)(hb + (size_t)m * DM) + lane; f32x4* p = (f32x4*)(a.out + (size_t)m * DM) + lane;
#pragma unroll
        for (int j = 0; j < 4; ++j) { const u32x2 r = hp[64 * j]; const f32x4 v = (f32x4){bflo(r.x), bfhi(r.x), bflo(r.y), bfhi(r.y)}; p[64 * j] = v * rs * gv[j]; }
    }
}

#define XB_TMO      128
#define XB_XCNT(j)  (256  + 64 * (j))
#define XB_XSUB(j)  (1280 + 64 * (j))
#define XB_XGEN(j)  (2304 + 64 * (j))
#define XB_TOP      3328
#define XB_TOPGEN   3392
#define XCD_BAR_WORDS 3456
#define XB_SPIN_CAP (1u << 22)
DI unsigned xb_ld(unsigned* p)              { return __hip_atomic_load(p, __ATOMIC_RELAXED, __HIP_MEMORY_SCOPE_AGENT); }
DI unsigned xb_add(unsigned* p, unsigned v) { return __hip_atomic_fetch_add(p, v, __ATOMIC_RELAXED, __HIP_MEMORY_SCOPE_AGENT); }
DI unsigned xb_xcc_id() { return (unsigned)__builtin_amdgcn_s_getreg((3 << 11) | 20) & 0xFu; }
#define XB_SPIN(cond, bar) do { unsigned _sp = 0; while (cond) { __builtin_amdgcn_s_sleep(1); \
    if ((++_sp & 255u) == 0u) { if (xb_ld(&(bar)[XB_TMO])) break; if (_sp > XB_SPIN_CAP) { atomicAdd(&(bar)[XB_TMO], 1u); break; } } } } while (0)
struct XcdBarrier { unsigned* bar; unsigned x; volatile LAS unsigned* st; };
DI XcdBarrier xcd_barrier_post(unsigned* bar, volatile LAS unsigned* st) {
    XcdBarrier b; b.bar = bar; b.x = xb_xcc_id(); b.st = st;
    if (threadIdx.x == 0) (void)xb_add(&bar[XB_XCNT(b.x)], 1u);
    return b;
}
DI void xcd_barrier_complete(unsigned* bar, unsigned x, unsigned& nloc, unsigned& nx) {
    const unsigned G = gridDim.x * gridDim.y * gridDim.z;
    unsigned sum, cnt, mine, sp = 0u;
    for (;;) {
        sum = 0u; cnt = 0u; mine = 0u;
#pragma unroll
        for (unsigned j = 0; j < 16; ++j) { const unsigned c = xb_ld(&bar[XB_XCNT(j)]); sum += c; cnt += (c > 0u) ? 1u : 0u; mine = (j == x) ? c : mine; }
        if (sum == G) break;
        __builtin_amdgcn_s_sleep(1);
        if ((++sp & 255u) == 0u) { if (xb_ld(&bar[XB_TMO])) break; if (sp > XB_SPIN_CAP) { atomicAdd(&bar[XB_TMO], 1u); break; } }
    }
    nloc = mine > 0u ? mine : 1u; nx = cnt > 0u ? cnt : 1u;
}
DI void xcd_barrier(const XcdBarrier& b) {
    asm volatile("s_waitcnt vmcnt(0)" ::: "memory");
    __syncthreads();
    if (threadIdx.x == 0) {
        unsigned* bar = b.bar;
        __builtin_amdgcn_s_waitcnt(0);
        unsigned nloc = b.st[0], nx = b.st[1];
        if (nloc == 0u) { xcd_barrier_complete(bar, b.x, nloc, nx); b.st[0] = nloc; b.st[1] = nx; }
        const unsigned old = xb_add(&bar[XB_XSUB(b.x)], 1u);
        const unsigned gen = old / nloc;
        if (old + 1u == (gen + 1u) * nloc) {
            __builtin_amdgcn_fence(__ATOMIC_RELEASE, "agent");
            asm volatile("s_waitcnt vmcnt(0)" ::: "memory");
            const unsigned og = xb_add(&bar[XB_TOP], 1u);
            const unsigned tg = og / nx;
            if (og + 1u == (tg + 1u) * nx) xb_add(&bar[XB_TOPGEN], 1u);
            else XB_SPIN(xb_ld(&bar[XB_TOPGEN]) == tg, bar);
            __builtin_amdgcn_fence(__ATOMIC_ACQUIRE, "agent");
            xb_add(&bar[XB_XGEN(b.x)], 1u);
            asm volatile("s_waitcnt vmcnt(0)" ::: "memory");
        } else {
            XB_SPIN(xb_ld(&bar[XB_XGEN(b.x)]) == gen, bar);
            __builtin_amdgcn_fence(__ATOMIC_ACQUIRE, "agent");
            asm volatile("s_waitcnt vmcnt(0)" ::: "memory");
        }
    }
    __syncthreads();
}

constexpr int NPHASE = 13;
#ifndef REP_MASK
#define REP_MASK 0
#endif
#ifndef USE_CG_SYNC
#define USE_CG_SYNC 0
#endif
#ifndef PH_MASK
#define PH_MASK 0xFFFF
#endif
#define PHM(k) (((PH_MASK) >> (k)) & 1)
__global__ void __launch_bounds__(NTHR, 2) mk_fwd(Args a) {
    extern __shared__ __attribute__((aligned(16))) unsigned char lds_raw[];
    LAS unsigned char* lds = (LAS unsigned char*)lds_raw;
    unsigned char* ws = a.ws;
    bf16_t* hb = (bf16_t*)(ws + WS_HB); float* ssq = (float*)(ws + WS_SSQ); float* H = a.out;
    volatile LAS unsigned* bst = (volatile LAS unsigned*)(lds + 131072 + 4096 + 23552);
    if (threadIdx.x < 4) bst[threadIdx.x] = 0u;
    __syncthreads();
    XcdBarrier xb = xcd_barrier_post((unsigned*)ws, bst);
    if (threadIdx.x == 0) { const unsigned xcc = xb.x & 7u; bst[2] = xcc; bst[3] = xb_add((unsigned*)ws + 4096 + 64 * xcc, 1u); }
    int vc = (int)blockIdx.x; bool vc_done = false;
    for (int pi = a.ph_lo; pi < a.ph_hi; ++pi) {
        const int ph = a.seq[pi];
        if (pi > 0 && !vc_done) {
            if (threadIdx.x == 0) { bool ok = (gridDim.x % 8u) == 0u;
                for (unsigned j = 0; j < 8; ++j) ok = ok && (xb_ld((unsigned*)ws + 4096 + 64 * j) == gridDim.x / 8u);
                bst[2] = ok ? (bst[2] + 8u * bst[3]) : blockIdx.x; }
            __syncthreads(); vc = __builtin_amdgcn_readfirstlane((int)bst[2]); vc_done = true;
        }
        if (PHM(0) && ph == 0) phase_prep(lds, a);
        else if (PHM(1) && ph == 1) { EpiScale E{(bf16_t*)(ws + WS_Z), 3072, (const LAS float*)(lds + RST_OFF)}; run_gemm<EpiScale, true>(lds, vc, hb, (const bf16_t*)(ws + WS_WIN0), MTOK, 3072, 1024, E, ssq); }
        else if (PHM(2) && ph == 2) phase_mixer0<false>(lds, a);
        else if (PHM(3) && ph == 3) phase_mixer0<true>(lds, a);
        else if (PHM(4) && (ph == 4 || ph == 9)) {
            EpiRes E{hb, ssq};
            run_gemm(lds, vc, (const bf16_t*)(ws + (ph == 4 ? WS_MIX : WS_SG)), (const bf16_t*)(ws + (ph == 4 ? WS_WOUT0 : WS_WOUT1)), MTOK, 1024, 1024, E);
        }
        else if (PHM(5) && ph == 7) { EpiGelu E{(bf16_t*)(ws + WS_UV), 2048, (const LAS float*)(lds + RST_OFF), a.in[16], (float*)(ws + WS_VST)}; run_gemm(lds, vc, hb, (const bf16_t*)(ws + WS_WIN1), MTOK, 2048, 1024, E, ssq); }
        else if (PHM(6) && ph == 8) phase_sgu(lds, a);
        else if (PHM(7) && ph == 12) phase_final(a);
        else if (PHM(8) && (ph == 5 || ph == 10)) {
            const int layer = (ph == 10);
            EpiFfn E{(bf16_t*)(ws + WS_ACT), (const LAS float*)(lds + RST_OFF), a.in[23] + (size_t)layer * 3 * DFF, a.in[24] + (size_t)layer * DFF, (LAS float*)(lds + 131072)};
            run_gemm_ffn(lds, vc, hb, (const bf16_t*)(ws + (layer ? WS_WUP1 : WS_WUP0)), ssq, E);
        }
        else if (PHM(9) && (ph == 6 || ph == 11)) {
            const int layer = (ph == 11);
            EpiRes E{hb, ssq}; run_gemm(lds, vc, (const bf16_t*)(ws + WS_ACT), (const bf16_t*)(ws + (layer ? WS_WDN1 : WS_WDN0)), MTOK, 1024, DFF, E);
        }
        if (pi + 1 < a.ph_hi) {
            if (USE_CG_SYNC || a.ph_hi > 1000) { __threadfence(); cg::this_grid().sync(); }
            else xcd_barrier(xb);
        }
    }
}

extern "C" void kernel_launch(void* const* d_in, const int* in_sizes, int n_in, void* d_out, int out_size, void* d_ws, size_t ws_size, hipStream_t stream) {
    static int grid = 0;
    if (grid == 0) {
        if (n_in != 26 || ws_size < WS_END) { fprintf(stderr, "kernel_launch: unexpected n_in %d / ws_size %zu (need %zu)\n", n_in, ws_size, (size_t)WS_END); grid = -1; return; }
        int dev = 0, cus = 0, per_cu = 0;
        (void)hipGetDevice(&dev); (void)hipDeviceGetAttribute(&cus, hipDeviceAttributeMultiprocessorCount, dev);
        if (hipFuncSetAttribute((const void*)mk_fwd, hipFuncAttributeMaxDynamicSharedMemorySize, LDS_BYTES) != hipSuccess) { fprintf(stderr, "kernel_launch: hipFuncSetAttribute failed\n"); grid = -1; return; }
        if (hipOccupancyMaxActiveBlocksPerMultiprocessor(&per_cu, (const void*)mk_fwd, NTHR, LDS_BYTES) != hipSuccess || per_cu < 1) { fprintf(stderr, "kernel_launch: occupancy query gave %d\n", per_cu); per_cu = 1; }
        (void)hipGetLastError();
        grid = cus * per_cu;
    }
    if (grid < 0) return;
    Args a{};
    for (int i = 0; i < 26; ++i) a.in[i] = (const float*)d_in[i];
    a.out = (float*)d_out; a.ws = (unsigned char*)d_ws;
#if ONE_LAUNCH
    { int n = 0; for (int ph = 0; ph < NPHASE; ++ph) { a.seq[n++] = ph; if ((REP_MASK >> ph) & 1) a.seq[n++] = ph; } a.ph_lo = 0; a.ph_hi = n; }
    if (hipMemsetAsync(d_ws, 0, 32768, stream) != hipSuccess) { fprintf(stderr, "kernel_launch: memset of the barrier words failed\n"); return; }
    void* args[] = {&a};
    hipError_t e = hipLaunchCooperativeKernel((const void*)mk_fwd, dim3(grid), dim3(NTHR), args, LDS_BYTES, stream);
    if (e != hipSuccess) fprintf(stderr, "cooperative launch failed: %s (grid %d)\n", hipGetErrorString(e), grid);
#else
    for (int ph = 0; ph < NPHASE; ++ph) {
        a.seq[0] = ph; a.ph_lo = 0; a.ph_hi = 1;
        hipLaunchKernelGGL(mk_fwd, dim3(grid), dim3(NTHR), LDS_BYTES, stream, a);
    }
#endif
}
```

```cpp
#include <hip/hip_runtime.h>
#include <hip/hip_cooperative_groups.h>
#include <cstdio>
namespace cg = cooperative_groups;

#ifndef ONE_LAUNCH
#define ONE_LAUNCH 1
#endif

#define LAS __attribute__((address_space(3)))
#define DI __device__ __forceinline__
typedef unsigned short bf16_t;
typedef short bf16x8 __attribute__((ext_vector_type(8)));
typedef float f32x4 __attribute__((ext_vector_type(4)));
typedef float f32x2 __attribute__((ext_vector_type(2)));
typedef unsigned u32x4 __attribute__((ext_vector_type(4)));
typedef unsigned u32x2 __attribute__((ext_vector_type(2)));

constexpr int MTOK = 65536, DM = 1024, TSEQ = 8192, NBATCH = 8, DFF = 2816;
constexpr int LDS_BYTES = 131072 + 4096 + 23552 + 16;
constexpr int NTHR = 512;

constexpr size_t MiB = 1024ull * 1024ull;
constexpr size_t WS_WIN0 = 1 * MiB;
constexpr size_t WS_WOUT0 = WS_WIN0 + 6 * MiB;
constexpr size_t WS_WUP0 = WS_WOUT0 + 2 * MiB;
constexpr size_t WS_WDN0 = WS_WUP0 + 11 * MiB;
constexpr size_t WS_WIN1 = WS_WDN0 + 11 * MiB / 2;
constexpr size_t WS_WOUT1 = WS_WIN1 + 4 * MiB;
constexpr size_t WS_WUP1 = WS_WOUT1 + 2 * MiB;
constexpr size_t WS_WDN1 = WS_WUP1 + 11 * MiB;
constexpr size_t WS_WSC = 48 * MiB;
constexpr size_t WS_SSQ = 49 * MiB;
constexpr size_t WS_VST = 53 * MiB;
constexpr size_t WS_LRUAGG = 61 * MiB;
constexpr size_t WS_HGD = 62 * MiB;
constexpr size_t WS_HGS = 63 * MiB;
constexpr size_t WS_HB = 80 * MiB;
constexpr size_t WS_R1 = 208 * MiB;
constexpr size_t WS_Z = WS_R1;
constexpr size_t WS_MIX = WS_R1 + 384 * MiB;
constexpr size_t WS_ACT = WS_R1;
constexpr size_t WS_UV = WS_R1;
constexpr size_t WS_SG = WS_R1 + 384 * MiB;
constexpr size_t WS_END = WS_R1 + 528 * MiB;

struct Args { const float* in[26]; float* out; unsigned char* ws; int ph_lo, ph_hi; int seq[32]; };

typedef __bf16 bf16x2_t __attribute__((ext_vector_type(2)));
DI unsigned cvt_pk_bf16(float lo, float hi) { const bf16x2_t v = __builtin_convertvector((f32x2){lo, hi}, bf16x2_t); return __builtin_bit_cast(unsigned, v); }
DI bf16_t f2bf(float f) { return (bf16_t)(cvt_pk_bf16(f, 0.f) & 0xffffu); }
DI float bf2f(bf16_t b) { return __builtin_bit_cast(float, (unsigned)b << 16); }
DI float bflo(unsigned w) { return __builtin_bit_cast(float, w << 16); }
DI float bfhi(unsigned w) { return __builtin_bit_cast(float, w & 0xffff0000u); }
DI int tid_() { int t = (int)threadIdx.x; asm volatile("" : "+v"(t)); return t; }
DI int bid_() { int b = __builtin_amdgcn_workgroup_id_x(); asm volatile("" : "+s"(b)); return b; }
DI float sigmoidf_(float x) { return __builtin_amdgcn_rcpf(1.0f + __builtin_amdgcn_exp2f(x * -1.44269504f)); }
DI float siluf_(float x) { return x * sigmoidf_(x); }
DI float geluf_(float x) { const float y = 1.5957691216f * (x + 0.044715f * x * x * x); return x * sigmoidf_(y); }
DI float wave_sum(float v) {
#pragma unroll
    for (int o = 1; o < 64; o <<= 1) v += __shfl_xor(v, o);
    return v;
}
DI f32x4 mma16(const LAS bf16_t* A, int lda, const LAS bf16_t* Bt, int ldb, int K, f32x4 acc, int lane) {
    const LAS bf16_t* a = A + (lane & 15) * lda + 8 * (lane >> 4);
    const LAS bf16_t* b = Bt + (lane & 15) * ldb + 8 * (lane >> 4);
#pragma unroll
    for (int k = 0; k < K; k += 32) {
        const bf16x8 av = *(const LAS bf16x8*)(a + k); const bf16x8 bv = *(const LAS bf16x8*)(b + k);
        acc = __builtin_amdgcn_mfma_f32_16x16x32_bf16(av, bv, acc, 0, 0, 0);
    }
    return acc;
}

namespace pg8 {
constexpr int BM = 256, BK = 64, HALF = 128, HTB = HALF * BK * 2, STAGE_BYTES = 8 * HTB, NXCD = 8, WGM = 8;
DI int lds_byte(int r, int c) { const int st = (r >> 4) * 2 + (c >> 5), rr = r & 15, cc = c & 31, ob = rr * 64 + cc * 2; return st * 1024 + (ob ^ (((ob >> 9) & 1) << 5)); }
DI void stage_rc(int b, int& R, int& C) { const int st = b / 1024, sb = b % 1024, swz = sb ^ (((sb >> 9) & 1) << 5); R = (st >> 1) * 16 + swz / 64; C = (st & 1) * 32 + (swz % 64) / 2; }
DI int perm32(int rho) { const int n = rho >> 4, i = rho & 15; return 8 * (i >> 2) + 4 * n + (i & 3); }
struct Unit { int pm, pn, arow, ord; };
struct Gemm { const bf16_t* A; const bf16_t* Bt; int M, N, K; };
struct StaticOrder {
    int nM, nN, nwg, G, c, ffn;
    DI void init(int M, int N, int G_, int c_) { nM = M / BM; nN = N / BM; nwg = nM * nN; G = G_; c = c_; ffn = 0; }
    DI void init_ffn(int G_, int c_) { nM = 264; nN = 22; nwg = nM * nN; G = G_; c = c_; ffn = 1; }
    DI bool next(int i, Unit& u) const {
        const long L = (long)i * G + c; if (L >= nwg) return false;
        int wgid = (int)L; { const int q = nwg / NXCD, r = nwg % NXCD, xcd = wgid % NXCD, off = wgid / NXCD; wgid = (xcd < r ? xcd * (q + 1) : r * (q + 1) + (xcd - r) * q) + off; }
        const int nig = WGM * nN, gid = wgid / nig, fm = gid * WGM, gsz = (nM - fm) < WGM ? (nM - fm) : WGM;
        u.pm = fm + ((wgid % nig) % gsz); u.pn = (wgid % nig) / gsz;
        if (ffn) { const int bb = u.pm / 33, ii = u.pm - bb * 33; u.arow = bb * 8192 + ii * 254 - 2; } else u.arow = u.pm * BM;
        return true;
    }
};

template <class Epi>
DI void gemm_phase(LAS unsigned char* lds, const Gemm g, const StaticOrder& S, const Epi& E) {
    const int tid = tid_(), wid = __builtin_amdgcn_readfirstlane(tid >> 6), lane = tid & 63, wr = wid >> 2, wc = wid & 3, fr = lane & 15, fq = lane >> 4;
    const int K = g.K, nt = K / BK;
    unsigned voffA[2], voffB[2];
#pragma unroll
    for (int i = 0; i < 2; ++i) { int R, C; stage_rc(tid * 16 + i * 8192, R, C); const int Rb = Epi::PERM ? ((R & ~31) + perm32(R & 31)) : R;
        voffA[i] = (unsigned)(R * K + C) * 2u; voffB[i] = (unsigned)(Rb * K + C) * 2u; }
    const size_t kstep = (size_t)(BK * 2);
    const size_t hstep = (size_t)HALF * K * 2;
    const size_t tstep = 2 * hstep;
    const unsigned ldsw = (unsigned)wid * 1024u;
    const int aoff = lds_byte(wr * 64 + fr, fq * 8), boff = lds_byte(wc * 32 + fr, fq * 8);
#define PG8_SA(b, h) (((b) * 2 + (h)) * HTB)
#define PG8_SB(b, h) ((4 + (b) * 2 + (h)) * HTB)
#define PG8_STAGE(bufoff, gbase, voff) do { _Pragma("unroll") for (int _i = 0; _i < 2; ++_i) \
        __builtin_amdgcn_global_load_lds((const unsigned*)((const char*)(gbase) + (voff)[_i]), (LAS unsigned*)(lds + (bufoff) + ldsw + _i * 8192), 16, 0, 0); } while (0)
#define PG8_LDA(dst, b, h) do { _Pragma("unroll") for (int m = 0; m < 4; ++m) _Pragma("unroll") for (int k = 0; k < 2; ++k) dst[m][k] = *(const LAS bf16x8*)(lds + PG8_SA(b, h) + aoff + m * 2048 + k * 1024); } while (0)
#define PG8_LDB(dst, b, h) do { _Pragma("unroll") for (int n = 0; n < 2; ++n) _Pragma("unroll") for (int k = 0; k < 2; ++k) dst[n][k] = *(const LAS bf16x8*)(lds + PG8_SB(b, h) + boff + n * 2048 + k * 1024); } while (0)
#define PG8_MMA(ai, bj, At, Bt) do { __builtin_amdgcn_s_setprio(1); _Pragma("unroll") for (int m = 0; m < 4; ++m) _Pragma("unroll") for (int n = 0; n < 2; ++n) _Pragma("unroll") for (int k = 0; k < 2; ++k) \
        acc[ai][bj][m][n] = __builtin_amdgcn_mfma_f32_16x16x32_bf16(Bt[n][k], At[m][k], acc[ai][bj][m][n], 0, 0, 0); __builtin_amdgcn_s_setprio(0); } while (0)
#define PG8_WAIT_V(n) asm volatile("s_waitcnt vmcnt(" #n ")" ::: "memory")
#define PG8_WAIT_L(n) asm volatile("s_waitcnt lgkmcnt(" #n ")" ::: "memory")
#define PG8_BAR __builtin_amdgcn_s_barrier()
#define PG8_SCHED __builtin_amdgcn_sched_barrier(0)
    Unit cur, nxt; nxt.pm = 0; nxt.pn = 0; nxt.arow = 0; nxt.ord = 0; int ui = 0;
    if (!S.next(0, cur)) return;
    cur.ord = 0;
    f32x4 acc[2][2][4][2];
#pragma unroll
    for (int a = 0; a < 2; ++a)
#pragma unroll
        for (int b = 0; b < 2; ++b)
#pragma unroll
            for (int m = 0; m < 4; ++m)
#pragma unroll
                for (int n = 0; n < 2; ++n) acc[a][b][m][n] = (f32x4){0.f, 0.f, 0.f, 0.f};
    bf16x8 At[4][2], B0[2][2], B1[2][2];
    const char* cA = (const char*)g.A + (ptrdiff_t)cur.arow * (ptrdiff_t)(K * 2); const char* cB = (const char*)g.Bt + (size_t)cur.pn * tstep;
    PG8_STAGE(PG8_SB(0, 0), cB, voffB); PG8_STAGE(PG8_SA(0, 0), cA, voffA); PG8_STAGE(PG8_SB(0, 1), cB + hstep, voffB); PG8_STAGE(PG8_SA(0, 1), cA + hstep, voffA);
    if (wr == 1) PG8_BAR;
    PG8_WAIT_V(4); PG8_BAR;
    PG8_STAGE(PG8_SB(1, 0), cB + kstep, voffB); PG8_STAGE(PG8_SA(1, 0), cA + kstep, voffA); PG8_STAGE(PG8_SB(1, 1), cB + hstep + kstep, voffB);
    PG8_WAIT_V(6); PG8_BAR;
    for (;;) {
        const bool has_next = S.next(ui + 1, nxt); nxt.ord = ui + 1;
        const char* nA = has_next ? (const char*)g.A + (ptrdiff_t)nxt.arow * (ptrdiff_t)(K * 2) : cA; const char* nB = has_next ? (const char*)g.Bt + (size_t)nxt.pn * tstep : cB;
        for (int t = 0; t < nt; t += 2) {
            const bool last = (t == nt - 2);
            const char* a1 = cA + (size_t)(t + 1) * kstep;
            const char* a2 = last ? nA : cA + (size_t)(t + 2) * kstep; const char* b2 = last ? nB : cB + (size_t)(t + 2) * kstep;
            const char* a3 = a2 + kstep; const char* b3 = b2 + kstep;
            PG8_LDB(B0, 0, 0); PG8_SCHED; PG8_LDA(At, 0, 0); PG8_STAGE(PG8_SA(1, 1), a1 + hstep, voffA);
            PG8_WAIT_L(8); PG8_BAR; PG8_WAIT_L(0); PG8_MMA(0, 0, At, B0); PG8_BAR; PG8_SCHED;
            PG8_LDB(B1, 0, 1); PG8_STAGE(PG8_SB(0, 0), b2, voffB);
            PG8_BAR; PG8_WAIT_L(0); PG8_MMA(0, 1, At, B1); PG8_BAR;
            PG8_LDA(At, 0, 1); PG8_STAGE(PG8_SA(0, 0), a2, voffA);
            PG8_BAR; PG8_WAIT_L(0); PG8_MMA(1, 0, At, B0); PG8_BAR; PG8_SCHED;
            PG8_STAGE(PG8_SB(0, 1), b2 + hstep, voffB);
            PG8_WAIT_V(6); PG8_BAR; PG8_MMA(1, 1, At, B1); PG8_BAR;
            PG8_LDB(B0, 1, 0); PG8_SCHED; PG8_LDA(At, 1, 0); PG8_STAGE(PG8_SA(0, 1), a2 + hstep, voffA);
            PG8_WAIT_L(8); PG8_BAR; PG8_WAIT_L(0); PG8_MMA(0, 0, At, B0); PG8_BAR; PG8_SCHED;
            PG8_LDB(B1, 1, 1); PG8_STAGE(PG8_SB(1, 0), b3, voffB);
            PG8_BAR; PG8_WAIT_L(0); PG8_MMA(0, 1, At, B1); PG8_BAR;
            PG8_LDA(At, 1, 1); PG8_STAGE(PG8_SA(1, 0), a3, voffA);
            PG8_BAR; PG8_WAIT_L(0); PG8_MMA(1, 0, At, B0); PG8_BAR; PG8_SCHED;
            PG8_STAGE(PG8_SB(1, 1), b3 + hstep, voffB);
            PG8_WAIT_V(6); PG8_BAR; PG8_MMA(1, 1, At, B1); PG8_BAR;
        }
        E(acc, cur, wr, wc, fr, fq);
        if (!has_next) break;
#pragma unroll
        for (int a = 0; a < 2; ++a)
#pragma unroll
            for (int b = 0; b < 2; ++b)
#pragma unroll
                for (int m = 0; m < 4; ++m)
#pragma unroll
                    for (int n = 0; n < 2; ++n) acc[a][b][m][n] = (f32x4){0.f, 0.f, 0.f, 0.f};
        cur = nxt; cA = nA; cB = nB; ++ui;
    }
    PG8_WAIT_V(0);
    if (wr == 0) PG8_BAR;
    PG8_BAR;
#undef PG8_SA
#undef PG8_SB
#undef PG8_STAGE
#undef PG8_LDA
#undef PG8_LDB
#undef PG8_MMA
#undef PG8_WAIT_V
#undef PG8_WAIT_L
#undef PG8_BAR
#undef PG8_SCHED
}
template <class Epi>
DI void gemm_phase4(LAS unsigned char* lds, const Gemm g, const StaticOrder& S, const Epi& E) {
    const int tid = tid_(), wid = __builtin_amdgcn_readfirstlane(tid >> 6), lane = tid & 63, wr = wid >> 2, wc = wid & 3, fr = lane & 15, fq = lane >> 4;
    const int K = g.K, nt = K / BK;
    unsigned voffA[2], voffB[2];
#pragma unroll
    for (int i = 0; i < 2; ++i) { int R, C; stage_rc(tid * 16 + i * 8192, R, C); const int Rb = Epi::PERM ? ((R & ~31) + perm32(R & 31)) : R;
        voffA[i] = (unsigned)(R * K + C) * 2u; voffB[i] = (unsigned)(Rb * K + C) * 2u; }
    const size_t kstep = (size_t)(BK * 2);
    const size_t hstep = (size_t)HALF * K * 2;
    const size_t tstep = 2 * hstep;
    const unsigned ldsw = (unsigned)wid * 1024u;
    const int aoff = lds_byte(wr * 64 + fr, fq * 8), boff = lds_byte(wc * 32 + fr, fq * 8);
#define PG8_SA(b, h) (((b) * 2 + (h)) * HTB)
#define PG8_SB(b, h) ((4 + (b) * 2 + (h)) * HTB)
#define PG8_STAGE(bufoff, gbase, voff) do { _Pragma("unroll") for (int _i = 0; _i < 2; ++_i) \
        __builtin_amdgcn_global_load_lds((const unsigned*)((const char*)(gbase) + (voff)[_i]), (LAS unsigned*)(lds + (bufoff) + ldsw + _i * 8192), 16, 0, 0); } while (0)
#define PG8_LDA(dst, b, h) do { _Pragma("unroll") for (int m = 0; m < 4; ++m) _Pragma("unroll") for (int k = 0; k < 2; ++k) dst[m][k] = *(const LAS bf16x8*)(lds + PG8_SA(b, h) + aoff + m * 2048 + k * 1024); } while (0)
#define PG8_LDB(dst, b, h) do { _Pragma("unroll") for (int n = 0; n < 2; ++n) _Pragma("unroll") for (int k = 0; k < 2; ++k) dst[n][k] = *(const LAS bf16x8*)(lds + PG8_SB(b, h) + boff + n * 2048 + k * 1024); } while (0)
#define PG8_MMA(ai, bj, At, Bt) do { __builtin_amdgcn_s_setprio(1); _Pragma("unroll") for (int m = 0; m < 4; ++m) _Pragma("unroll") for (int n = 0; n < 2; ++n) _Pragma("unroll") for (int k = 0; k < 2; ++k) \
        acc[ai][bj][m][n] = __builtin_amdgcn_mfma_f32_16x16x32_bf16(Bt[n][k], At[m][k], acc[ai][bj][m][n], 0, 0, 0); __builtin_amdgcn_s_setprio(0); } while (0)
#define PG8_WAIT_V(n) asm volatile("s_waitcnt vmcnt(" #n ")" ::: "memory")
#define PG8_WAIT_L(n) asm volatile("s_waitcnt lgkmcnt(" #n ")" ::: "memory")
#define PG8_BAR __builtin_amdgcn_s_barrier()
#define PG8_SCHED __builtin_amdgcn_sched_barrier(0)
    Unit cur, nxt; nxt.pm = 0; nxt.pn = 0; nxt.arow = 0; nxt.ord = 0; int ui = 0;
    if (!S.next(0, cur)) return;
    cur.ord = 0;
    f32x4 acc[2][2][4][2];
#pragma unroll
    for (int a = 0; a < 2; ++a)
#pragma unroll
        for (int b = 0; b < 2; ++b)
#pragma unroll
            for (int m = 0; m < 4; ++m)
#pragma unroll
                for (int n = 0; n < 2; ++n) acc[a][b][m][n] = (f32x4){0.f, 0.f, 0.f, 0.f};
    bf16x8 At[4][2], B0[2][2], B1[2][2];
    const char* cA = (const char*)g.A + (ptrdiff_t)cur.arow * (ptrdiff_t)(K * 2); const char* cB = (const char*)g.Bt + (size_t)cur.pn * tstep;
    PG8_STAGE(PG8_SB(0, 0), cB, voffB); PG8_STAGE(PG8_SA(0, 0), cA, voffA); PG8_STAGE(PG8_SB(0, 1), cB + hstep, voffB); PG8_STAGE(PG8_SA(0, 1), cA + hstep, voffA);
    if (wr == 1) PG8_BAR;
    PG8_WAIT_V(0); PG8_BAR;
    PG8_STAGE(PG8_SB(1, 0), cB + kstep, voffB); PG8_STAGE(PG8_SA(1, 0), cA + kstep, voffA); PG8_STAGE(PG8_SB(1, 1), cB + hstep + kstep, voffB);
    PG8_BAR;
    for (;;) {
        const bool has_next = S.next(ui + 1, nxt); nxt.ord = ui + 1;
        const char* nA = has_next ? (const char*)g.A + (ptrdiff_t)nxt.arow * (ptrdiff_t)(K * 2) : cA; const char* nB = has_next ? (const char*)g.Bt + (size_t)nxt.pn * tstep : cB;
        for (int t = 0; t < nt; t += 2) {
            const bool last = (t == nt - 2);
            const char* a1 = cA + (size_t)(t + 1) * kstep;
            const char* a2 = last ? nA : cA + (size_t)(t + 2) * kstep; const char* b2 = last ? nB : cB + (size_t)(t + 2) * kstep;
            const char* a3 = a2 + kstep; const char* b3 = b2 + kstep;
            PG8_LDB(B0, 0, 0); PG8_LDB(B1, 0, 1); PG8_LDA(At, 0, 0); PG8_STAGE(PG8_SA(1, 1), a1 + hstep, voffA);
            PG8_WAIT_V(8); PG8_WAIT_L(0); PG8_BAR; PG8_MMA(0, 0, At, B0); PG8_MMA(0, 1, At, B1); PG8_BAR; PG8_SCHED;
            PG8_LDA(At, 0, 1); PG8_STAGE(PG8_SB(0, 0), b2, voffB); PG8_STAGE(PG8_SA(0, 0), a2, voffA); PG8_STAGE(PG8_SB(0, 1), b2 + hstep, voffB);
            PG8_WAIT_V(8); PG8_WAIT_L(0); PG8_BAR; PG8_MMA(1, 0, At, B0); PG8_MMA(1, 1, At, B1); PG8_BAR; PG8_SCHED;
            PG8_LDB(B0, 1, 0); PG8_LDB(B1, 1, 1); PG8_LDA(At, 1, 0); PG8_STAGE(PG8_SA(0, 1), a2 + hstep, voffA);
            PG8_WAIT_V(8); PG8_WAIT_L(0); PG8_BAR; PG8_MMA(0, 0, At, B0); PG8_MMA(0, 1, At, B1); PG8_BAR; PG8_SCHED;
            PG8_LDA(At, 1, 1); PG8_STAGE(PG8_SB(1, 0), b3, voffB); PG8_STAGE(PG8_SA(1, 0), a3, voffA); PG8_STAGE(PG8_SB(1, 1), b3 + hstep, voffB);
            PG8_WAIT_V(8); PG8_WAIT_L(0); PG8_BAR; PG8_MMA(1, 0, At, B0); PG8_MMA(1, 1, At, B1); PG8_BAR; PG8_SCHED;
        }
        E(acc, cur, wr, wc, fr, fq);
        if (!has_next) break;
#pragma unroll
        for (int a = 0; a < 2; ++a)
#pragma unroll
            for (int b = 0; b < 2; ++b)
#pragma unroll
                for (int m = 0; m < 4; ++m)
#pragma unroll
                    for (int n = 0; n < 2; ++n) acc[a][b][m][n] = (f32x4){0.f, 0.f, 0.f, 0.f};
        cur = nxt; cA = nA; cB = nB; ++ui;
    }
    PG8_WAIT_V(0);
    if (wr == 0) PG8_BAR;
    PG8_BAR;
#undef PG8_SA
#undef PG8_SB
#undef PG8_STAGE
#undef PG8_LDA
#undef PG8_LDB
#undef PG8_MMA
#undef PG8_WAIT_V
#undef PG8_WAIT_L
#undef PG8_BAR
#undef PG8_SCHED
}
}

DI float ssq_rs(const float* ssq, size_t row) {
    const f32x4* q = (const f32x4*)(ssq + row * 16);
    const f32x4 a = q[0], b = q[1], c = q[2], d = q[3];
    const float s = (((a[0] + a[1]) + (a[2] + a[3])) + ((b[0] + b[1]) + (b[2] + b[3]))) + (((c[0] + c[1]) + (c[2] + c[3])) + ((d[0] + d[1]) + (d[2] + d[3])));
    return rsqrtf(s * (1.0f / 1024.0f) + 1e-6f);
}

constexpr int RST_OFF = 131072 + 4096, RST_MAXU = 23;
DI void build_rstab(LAS unsigned char* lds, const pg8::StaticOrder& S, const float* ssq, int row_max) {
    LAS float* RST = (LAS float*)(lds + RST_OFF);
    const int tid = tid_(), r = tid & 255, par = tid >> 8;
    for (int i = par; i < RST_MAXU; i += 2) { pg8::Unit u; if (!S.next(i, u)) break;
        int grow = u.arow + r; grow = grow < 0 ? 0 : (grow > row_max ? row_max : grow);
        RST[i * 256 + r] = ssq_rs(ssq, (size_t)grow); }
    __syncthreads();
}
struct EpiScale {
    static constexpr bool PERM = true;
    bf16_t* O; int ldc; const LAS float* RST;
    DI void operator()(const f32x4 (&acc)[2][2][4][2], const pg8::Unit& u, int wr, int wc, int fr, int fq) const {
        const int row0 = u.pm * 256 + wr * 64 + fr, col0 = u.pn * 256 + wc * 32 + 8 * fq;
        const int tsel = u.pn >> 1; const int actsel = (tsel == 0) ? 1 : ((tsel == 2 || tsel == 5) ? 2 : 0);
#pragma unroll
        for (int ai = 0; ai < 2; ++ai)
#pragma unroll
            for (int m = 0; m < 4; ++m) {
                const size_t row = (size_t)(row0 + ai * 128 + m * 16); const float rs = RST[u.ord * 256 + wr * 64 + fr + ai * 128 + m * 16];
                bf16_t* rowp = O + row * ldc + col0;
#pragma unroll
                for (int bj = 0; bj < 2; ++bj) { f32x4 v0 = acc[ai][bj][m][0] * rs, v1 = acc[ai][bj][m][1] * rs;
                    if (actsel == 1) {
#pragma unroll
                        for (int j = 0; j < 4; ++j) { v0[j] = geluf_(v0[j]); v1[j] = geluf_(v1[j]); } }
                    else if (actsel == 2) {
#pragma unroll
                        for (int j = 0; j < 4; ++j) { v0[j] = siluf_(v0[j]); v1[j] = siluf_(v1[j]); } }
                    u32x4 w; w.x = cvt_pk_bf16(v0[0], v0[1]); w.y = cvt_pk_bf16(v0[2], v0[3]); w.z = cvt_pk_bf16(v1[0], v1[1]); w.w = cvt_pk_bf16(v1[2], v1[3]);
                    *(u32x4*)(rowp + bj * 128) = w; }
            }
    }
};
struct EpiGelu {
    static constexpr bool PERM = true;
    bf16_t* O; int ldc; const LAS float* RST; const float* bias; float* vst;
    DI void operator()(const f32x4 (&acc)[2][2][4][2], const pg8::Unit& u, int wr, int wc, int fr, int fq) const {
        const int row0 = u.pm * 256 + wr * 64 + fr, col0 = u.pn * 256 + wc * 32 + 8 * fq;
        f32x4 bv[2][2];
#pragma unroll
        for (int bj = 0; bj < 2; ++bj)
#pragma unroll
            for (int n = 0; n < 2; ++n) bv[bj][n] = *(const f32x4*)(bias + col0 + bj * 128 + 4 * n);
#pragma unroll
        for (int ai = 0; ai < 2; ++ai)
#pragma unroll
            for (int m = 0; m < 4; ++m) {
                const size_t row = (size_t)(row0 + ai * 128 + m * 16); const float rs = RST[u.ord * 256 + wr * 64 + fr + ai * 128 + m * 16];
                bf16_t* rowp = O + row * ldc + col0; float s1 = 0.f, s2 = 0.f;
#pragma unroll
                for (int bj = 0; bj < 2; ++bj) { f32x4 v0 = acc[ai][bj][m][0] * rs + bv[bj][0], v1 = acc[ai][bj][m][1] * rs + bv[bj][1];
#pragma unroll
                    for (int j = 0; j < 4; ++j) { v0[j] = geluf_(v0[j]); v1[j] = geluf_(v1[j]); s1 += v0[j] + v1[j]; s2 += v0[j] * v0[j] + v1[j] * v1[j]; }
                    u32x4 w; w.x = cvt_pk_bf16(v0[0], v0[1]); w.y = cvt_pk_bf16(v0[2], v0[3]); w.z = cvt_pk_bf16(v1[0], v1[1]); w.w = cvt_pk_bf16(v1[2], v1[3]);
                    *(u32x4*)(rowp + bj * 128) = w; }
                if (u.pn >= 4) {
                    s1 += __shfl_xor(s1, 16); s1 += __shfl_xor(s1, 32); s2 += __shfl_xor(s2, 16); s2 += __shfl_xor(s2, 32);
                    if (fq == 0) *(f32x2*)(vst + (row * 16 + (size_t)((u.pn - 4) * 4 + wc)) * 2) = (f32x2){s1, s2};
                }
            }
    }
};
struct EpiRes {
    static constexpr bool PERM = false;
    bf16_t* hb; float* ssq;
    DI void operator()(const f32x4 (&acc)[2][2][4][2], const pg8::Unit& u, int wr, int wc, int fr, int fq) const {
        const int row0 = u.pm * 256 + wr * 64 + fr, col0 = u.pn * 256 + wc * 32 + 4 * fq;
#pragma unroll
        for (int ai = 0; ai < 2; ++ai) {
            u32x2 rr[4][2][2];
#pragma unroll
            for (int m = 0; m < 4; ++m) { const size_t off = (size_t)(row0 + ai * 128 + m * 16) * DM + col0;
#pragma unroll
                for (int bj = 0; bj < 2; ++bj)
#pragma unroll
                    for (int n = 0; n < 2; ++n) rr[m][bj][n] = *(const u32x2*)(hb + off + bj * 128 + n * 16); }
#pragma unroll
            for (int m = 0; m < 4; ++m) { const size_t row = (size_t)(row0 + ai * 128 + m * 16); const size_t off = row * DM + col0; float sq = 0.f;
#pragma unroll
                for (int bj = 0; bj < 2; ++bj)
#pragma unroll
                    for (int n = 0; n < 2; ++n) {
                        const u32x2 r = rr[m][bj][n]; const f32x4 v = acc[ai][bj][m][n] + (f32x4){bflo(r.x), bfhi(r.x), bflo(r.y), bfhi(r.y)};
                        u32x2 w; w.x = cvt_pk_bf16(v[0], v[1]); w.y = cvt_pk_bf16(v[2], v[3]); *(u32x2*)(hb + off + bj * 128 + n * 16) = w;
                        sq += (v[0] * v[0] + v[1] * v[1]) + (v[2] * v[2] + v[3] * v[3]);
                    }
                sq += __shfl_xor(sq, 16); sq += __shfl_xor(sq, 32);
                if (fq == 0) ssq[row * 16 + (size_t)(u.pn * 4 + wc)] = sq; }
        }
    }
};

template <int CTRL> DI float dppmov(float oldv, float src) { return __builtin_bit_cast(float, __builtin_amdgcn_update_dpp(__builtin_bit_cast(int, oldv), __builtin_bit_cast(int, src), CTRL, 0xf, 0xf, false)); }
struct EpiFfn {
    static constexpr bool PERM = true;
    bf16_t* act; const LAS float* RST; const float* cw; const float* cb; LAS float* X;
    DI void operator()(f32x4 (&acc)[2][2][4][2], const pg8::Unit& u, int wr, int wc, int fr_, int fq_) const {
        int fr = fr_, fq = fq_; asm volatile("" : "+v"(fr), "+v"(fq));
        const int bb = u.pm / 33, ii = u.pm - bb * 33; const int tok0 = ii * 254 - 2;
        const int chl = wc * 32 + 8 * fq, ch = u.pn * 128 + chl;
#pragma unroll
        for (int ai = 0; ai < 2; ++ai)
#pragma unroll
            for (int m = 0; m < 4; ++m) {
                const int r = 128 * ai + 64 * wr + 16 * m + fr, tok = tok0 + r;
                const float rs = RST[u.ord * 256 + r];
#pragma unroll
                for (int n = 0; n < 2; ++n) { acc[ai][0][m][n] = (tok >= 0) ? acc[ai][0][m][n] * rs : (f32x4){0.f, 0.f, 0.f, 0.f}; acc[ai][1][m][n] = acc[ai][1][m][n] * rs; }
            }
#pragma unroll
        for (int ai = 0; ai < 2; ++ai) { const int slot = ai * 2 + wr;
            if (fr >= 14) {
#pragma unroll
                for (int n = 0; n < 2; ++n) *(LAS f32x4*)(X + ((slot * 2 + (fr - 14)) * 128 + chl + 4 * n)) = acc[ai][0][3][n]; } }
        asm volatile("s_waitcnt lgkmcnt(0)" ::: "memory"); __builtin_amdgcn_s_barrier(); asm volatile("" ::: "memory"); __builtin_amdgcn_s_barrier(); asm volatile("" ::: "memory");
        f32x4 w0[2], w1[2], w2[2], bv[2];
#pragma unroll
        for (int n = 0; n < 2; ++n) { w0[n] = *(const f32x4*)(cw + ch + 4 * n); w1[n] = *(const f32x4*)(cw + DFF + ch + 4 * n); w2[n] = *(const f32x4*)(cw + 2 * DFF + ch + 4 * n); bv[n] = *(const f32x4*)(cb + ch + 4 * n); }
#pragma unroll
        for (int ai = 0; ai < 2; ++ai) {
            const int slot = ai * 2 + wr; f32x4 prev[2];
            { const int rowsel = (fr == 15) ? 1 : 0; const int sl = slot > 0 ? slot - 1 : 0;
#pragma unroll
              for (int n = 0; n < 2; ++n) { prev[n] = *(const LAS f32x4*)(X + ((sl * 2 + rowsel) * 128 + chl + 4 * n)); if (slot == 0) prev[n] = (f32x4){0.f, 0.f, 0.f, 0.f}; } }
#pragma unroll
            for (int m = 0; m < 4; ++m) {
                const int r = 128 * ai + 64 * wr + 16 * m + fr, tok = tok0 + r; float o[8];
#pragma unroll
                for (int n = 0; n < 2; ++n)
#pragma unroll
                    for (int j = 0; j < 4; ++j) { const float g0 = acc[ai][0][m][n][j], p = prev[n][j];
                        const float rot1 = dppmov<0x121>(p, p), rot2 = dppmov<0x122>(p, p);
                        const float g1 = dppmov<0x111>(rot1, g0), g2 = dppmov<0x112>(rot2, g0);
                        const float cv = bv[n][j] + w0[n][j] * g2 + w1[n][j] * g1 + w2[n][j] * g0;
                        o[n * 4 + j] = siluf_(cv) * acc[ai][1][m][n][j]; }
                u32x4 ow; ow.x = cvt_pk_bf16(o[0], o[1]); ow.y = cvt_pk_bf16(o[2], o[3]); ow.z = cvt_pk_bf16(o[4], o[5]); ow.w = cvt_pk_bf16(o[6], o[7]);
                if (r >= 2 && tok < TSEQ) *(u32x4*)(act + (size_t)(bb * 8192 + tok) * DFF + ch) = ow;
                prev[0] = acc[ai][0][m][0]; prev[1] = acc[ai][0][m][1];
            }
        }
    }
};

template <class Epi> DI void run_gemm_ffn(LAS unsigned char* lds, int vc, const bf16_t* A, const bf16_t* Bt, const float* ssq, const Epi& E) {
    pg8::Gemm g{A, Bt, MTOK, 5632, 1024}; pg8::StaticOrder S; S.init_ffn((int)gridDim.x, vc);
    build_rstab(lds, S, ssq, MTOK - 1);
    pg8::gemm_phase4<Epi>(lds, g, S, E);
}
template <class Epi, bool P4 = true> DI void run_gemm(LAS unsigned char* lds, int vc, const bf16_t* A, const bf16_t* Bt, int Mrows, int N, int K, const Epi& E, const float* ssq = nullptr) {
    pg8::Gemm g{A, Bt, Mrows, N, K}; pg8::StaticOrder S; S.init(Mrows, N, (int)gridDim.x, vc);
    if (ssq) build_rstab(lds, S, ssq, Mrows - 1);
    if (P4) pg8::gemm_phase4<Epi>(lds, g, S, E); else pg8::gemm_phase<Epi>(lds, g, S, E);
}

DI void transpose_item(const float* W, int K, int N, bf16_t* WT, const float* gain, LAS float* scr, int item, int lane, bool ffn_remap = false) {
    const int nblk = N / 32, kb = item / nblk, nb = item % nblk, k0 = 64 * kb, n0 = 32 * nb;
    const int r0 = ffn_remap ? ((n0 < DFF) ? (n0 / 128) * 256 + (n0 % 128) : ((n0 - DFF) / 128) * 256 + 128 + ((n0 - DFF) % 128)) : n0;
#pragma unroll 8
    for (int i = 0; i < 32; ++i) { const int kk = 2 * i + (lane >> 5); float v = W[(size_t)(k0 + kk) * N + n0 + (lane & 31)]; if (gain) v *= gain[k0 + kk]; scr[kk * 33 + (lane & 31)] = v; }
    asm volatile("s_waitcnt lgkmcnt(0)" ::: "memory");
    const int c = lane & 7;
#pragma unroll
    for (int j = 0; j < 4; ++j) { const int n = (lane >> 3) + 8 * j; const LAS float* s = scr + (8 * c) * 33 + n;
        u32x4 o; o.x = cvt_pk_bf16(s[0 * 33], s[1 * 33]); o.y = cvt_pk_bf16(s[2 * 33], s[3 * 33]); o.z = cvt_pk_bf16(s[4 * 33], s[5 * 33]); o.w = cvt_pk_bf16(s[6 * 33], s[7 * 33]);
        *(u32x4*)(WT + (size_t)(r0 + n) * K + k0 + 8 * c) = o; }
    asm volatile("s_waitcnt lgkmcnt(0)" ::: "memory");
}
DI void phase_prep(LAS unsigned char* lds, const Args& a) {
    const int tid = tid_(), lane = tid & 63, wave = tid >> 6;
    const int gw = bid_() * 8 + wave, NGW = (int)gridDim.x * 8;
    unsigned char* ws = a.ws;
    LAS float* scr = (LAS float*)(lds + wave * 8448);
    constexpr int I_IN0 = 16 * 96, I_OUT = 16 * 32, I_UP = 16 * 176, I_DN = 44 * 32, I_IN1 = 16 * 64;
    constexpr int NITEMS = I_IN0 + I_OUT + I_UP + I_DN + I_IN1 + I_OUT + I_UP + I_DN;
    for (int it = gw; it < NITEMS; it += NGW) {
        int r = it;
        if (r < I_IN0) { transpose_item(a.in[4], 1024, 3072, (bf16_t*)(ws + WS_WIN0), a.in[1], scr, r, lane); continue; } r -= I_IN0;
        if (r < I_OUT) { transpose_item(a.in[14], 1024, 1024, (bf16_t*)(ws + WS_WOUT0), nullptr, scr, r, lane); continue; } r -= I_OUT;
        if (r < I_UP) { transpose_item(a.in[22], 1024, 5632, (bf16_t*)(ws + WS_WUP0), a.in[2], scr, r, lane, true); continue; } r -= I_UP;
        if (r < I_DN) { transpose_item(a.in[25], 2816, 1024, (bf16_t*)(ws + WS_WDN0), nullptr, scr, r, lane); continue; } r -= I_DN;
        if (r < I_IN1) { transpose_item(a.in[15], 1024, 2048, (bf16_t*)(ws + WS_WIN1), a.in[1] + 1024, scr, r, lane); continue; } r -= I_IN1;
        if (r < I_OUT) { transpose_item(a.in[21], 1024, 1024, (bf16_t*)(ws + WS_WOUT1), nullptr, scr, r, lane); continue; } r -= I_OUT;
        if (r < I_UP) { transpose_item(a.in[22] + (size_t)1024 * 5632, 1024, 5632, (bf16_t*)(ws + WS_WUP1), a.in[2] + 1024, scr, r, lane, true); continue; } r -= I_UP;
        transpose_item(a.in[25] + (size_t)2816 * 1024, 2816, 1024, (bf16_t*)(ws + WS_WDN1), nullptr, scr, r, lane);
    }
    { const float* w_s = a.in[19]; bf16_t* wsc = (bf16_t*)(ws + WS_WSC);
      for (int i = bid_() * NTHR + tid; i < 8 * 128 * 128; i += (int)gridDim.x * NTHR) { const int t = (i >> 7) & 127, s = i & 127; wsc[i] = (s <= t) ? f2bf(w_s[i]) : (bf16_t)0; } }
    { const float* x = a.in[0]; bf16_t* xb = (bf16_t*)(ws + WS_HB); float* ssq = (float*)(ws + WS_SSQ);
      for (int m = gw; m < MTOK; m += NGW) {
          const f32x4* xr = (const f32x4*)(x + (size_t)m * DM) + lane; f32x4 v[4]; float s = 0.f;
#pragma unroll
          for (int j = 0; j < 4; ++j) { v[j] = xr[64 * j]; s += (v[j][0] * v[j][0] + v[j][1] * v[j][1]) + (v[j][2] * v[j][2] + v[j][3] * v[j][3]); }
          s = wave_sum(s);
          u32x2* o8 = (u32x2*)(xb + (size_t)m * DM) + lane;
#pragma unroll
          for (int j = 0; j < 4; ++j) { u32x2 w; w.x = cvt_pk_bf16(v[j][0], v[j][1]); w.y = cvt_pk_bf16(v[j][2], v[j][3]); o8[64 * j] = w; }
          if (lane < 16) ssq[(size_t)m * 16 + lane] = (lane == 0) ? s : 0.f;
      } }
}

template <bool FINAL>
DI void lru_item(LAS unsigned char* lds, const Args& a, int it) {
    const int tid = tid_(), lane = tid & 63, w = tid >> 6;
    const int b = it >> 5, cb = (it >> 2) & 7, seg = it & 3;
    const bf16_t* z = (const bf16_t*)(a.ws + WS_Z); bf16_t* mix = (bf16_t*)(a.ws + WS_MIX); float* agg = (float*)(a.ws + WS_LRUAGG);
    LAS bf16_t* WaT = (LAS bf16_t*)lds;
    LAS bf16_t* WxT = WaT + 64 * 72;
    LAS bf16_t* XR = WxT + 64 * 72;
    LAS bf16_t* XC = XR + 132 * 64;
    LAS float* AA = (LAS float*)(XC + 128 * 72);
    LAS float* UU = AA + 128 * 64;
    LAS float* SPp = UU + 128 * 64;
    LAS float* SHh = SPp + 512;
    LAS float* TAB = SHh + 512;
    LAS bf16_t* YT = (LAS bf16_t*)(TAB + 512);
    static_assert((64 * 72 * 2 + 132 * 64 + 128 * 72) * 2 + (128 * 64 * 2 + 512 * 3) * 4 + 128 * 64 * 2 <= 158720, "lru lds");
    { const float* wa = a.in[7] + cb * 4096; const float* wx = a.in[9] + cb * 4096;
#pragma unroll
      for (int r = 0; r < 8; ++r) { const int e = tid + 512 * r, i = e >> 6, j = e & 63; WaT[j * 72 + i] = f2bf(wa[e]); WxT[j * 72 + i] = f2bf(wx[e]); }
      if (tid < 64) { const int ch = cb * 64 + tid;
#pragma unroll
          for (int k = 0; k < 4; ++k) TAB[k * 64 + tid] = a.in[5][k * 512 + ch];
          TAB[256 + tid] = a.in[6][ch]; TAB[320 + tid] = a.in[8][ch]; TAB[384 + tid] = a.in[10][ch]; TAB[448 + tid] = log1pf(expf(-a.in[11][ch])); } }
    const int c = tid & 63, sub = tid >> 6;
    float h = 0.f, Ptot = 1.f;
    if (FINAL) for (int j = 0; j < seg; ++j) { const f32x2 pq = *(const f32x2*)(agg + ((size_t)((b * 4 + j) * 512 + cb * 64 + c)) * 2); h = pq[0] * h + pq[1]; }
    const bf16_t* zb = z + (size_t)b * TSEQ * 3072 + cb * 64 + (tid & 7) * 8;
    const int prow = tid >> 3;
    u32x4 pfx[3], pfy[2];
    { const int t0 = seg * 2048;
#pragma unroll
      for (int k = 0; k < 3; ++k) { const int r = prow + 64 * k, tok = t0 - 3 + r; u32x4 v = (u32x4){0u, 0u, 0u, 0u};
          if (r < 131 && tok >= 0) v = *(const u32x4*)(zb + (size_t)tok * 3072 + 512);
          if (r < 131) *(LAS u32x4*)(XR + r * 64 + (tid & 7) * 8) = v; }
      if (FINAL) {
#pragma unroll
          for (int k = 0; k < 2; ++k) pfy[k] = *(const u32x4*)(zb + (size_t)(t0 + prow + 64 * k) * 3072); } }
    __syncthreads();
    const float cw0 = TAB[c], cw1 = TAB[64 + c], cw2 = TAB[128 + c], cw3 = TAB[192 + c], cbv = TAB[256 + c];
    for (int tile = 0; tile < 16; ++tile) {
        const int t0 = seg * 2048 + tile * 128; const bool more = tile + 1 < 16;
        if (more) {
#pragma unroll
            for (int k = 0; k < 3; ++k) { const int r = prow + 64 * k; if (r < 131) pfx[k] = *(const u32x4*)(zb + (size_t)(t0 + 128 - 3 + r) * 3072 + 512); }
        }
#pragma unroll
        for (int i = 0; i < 16; ++i) { const int t = sub + 8 * i;
            const float xc = cbv + cw0 * bf2f(XR[t * 64 + c]) + cw1 * bf2f(XR[(t + 1) * 64 + c]) + cw2 * bf2f(XR[(t + 2) * 64 + c]) + cw3 * bf2f(XR[(t + 3) * 64 + c]);
            XC[t * 72 + c] = f2bf(xc); }
        __syncthreads();
        if (FINAL) {
#pragma unroll
            for (int k = 0; k < 2; ++k) *(LAS u32x4*)(YT + (prow + 64 * k) * 64 + (tid & 7) * 8) = pfy[k];
            if (more) {
#pragma unroll
                for (int k = 0; k < 2; ++k) pfy[k] = *(const u32x4*)(zb + (size_t)(t0 + 128 + prow + 64 * k) * 3072); }
        }
        {
            f32x4 accA[4], accX[4];
#pragma unroll
            for (int nt = 0; nt < 4; ++nt) { accA[nt] = (f32x4){0.f, 0.f, 0.f, 0.f}; accX[nt] = (f32x4){0.f, 0.f, 0.f, 0.f}; }
#pragma unroll
            for (int k = 0; k < 2; ++k) { const bf16x8 av = *(const LAS bf16x8*)(XC + (w * 16 + (lane & 15)) * 72 + k * 32 + 8 * (lane >> 4));
#pragma unroll
                for (int nt = 0; nt < 4; ++nt) { const bf16x8 ba = *(const LAS bf16x8*)(WaT + (nt * 16 + (lane & 15)) * 72 + k * 32 + 8 * (lane >> 4)), bx = *(const LAS bf16x8*)(WxT + (nt * 16 + (lane & 15)) * 72 + k * 32 + 8 * (lane >> 4));
                    accA[nt] = __builtin_amdgcn_mfma_f32_16x16x32_bf16(av, ba, accA[nt], 0, 0, 0); accX[nt] = __builtin_amdgcn_mfma_f32_16x16x32_bf16(av, bx, accX[nt], 0, 0, 0); } }
#pragma unroll
            for (int nt = 0; nt < 4; ++nt) { const int cc = nt * 16 + (lane & 15);
                const float ba = TAB[320 + cc], bx = TAB[384 + cc], spl = TAB[448 + cc];
#pragma unroll
                for (int j = 0; j < 4; ++j) { const int t = w * 16 + 4 * (lane >> 4) + j;
                    const float r = sigmoidf_(accA[nt][j] + ba), ig = sigmoidf_(accX[nt][j] + bx);
                    const float av = __expf(-8.0f * r * spl);
                    const float xc = bf2f(XC[t * 72 + cc]);
                    AA[t * 64 + cc] = av; UU[t * 64 + cc] = __builtin_amdgcn_sqrtf(fmaxf(1.0f - av * av, 0.f)) * (ig * xc); }
            }
        }
        __syncthreads();
        if (more) {
#pragma unroll
            for (int k = 0; k < 3; ++k) { const int r = prow + 64 * k; if (r < 131) *(LAS u32x4*)(XR + r * 64 + (tid & 7) * 8) = pfx[k]; }
        }
        { float P = 1.f, Hh = 0.f;
#pragma unroll
          for (int i = 0; i < 16; ++i) { const int t = sub * 16 + i; const float a_ = AA[t * 64 + c], u_ = UU[t * 64 + c]; Hh = a_ * Hh + u_; P *= a_; }
          SPp[sub * 64 + c] = P; SHh[sub * 64 + c] = Hh; }
        __syncthreads();
        float hin = h;
#pragma unroll
        for (int s = 0; s < 8; ++s) { const float p = SPp[s * 64 + c], q = SHh[s * 64 + c]; if (s < sub) hin = p * hin + q; h = p * h + q; Ptot *= p; }
        if (FINAL) {
            float hh = hin;
#pragma unroll
            for (int i = 0; i < 16; ++i) { const int t = sub * 16 + i;
                hh = AA[t * 64 + c] * hh + UU[t * 64 + c];
                const float y = bf2f(YT[t * 64 + c]);
                YT[t * 64 + c] = f2bf(y * hh); }
            __syncthreads();
#pragma unroll
            for (int k = 0; k < 2; ++k) { const int r = prow + 64 * k;
                *(u32x4*)(mix + ((size_t)b * TSEQ + t0 + r) * 1024 + cb * 64 + (tid & 7) * 8) = *(const LAS u32x4*)(YT + r * 64 + (tid & 7) * 8); }
        }
    }
    if (!FINAL && sub == 0) *(f32x2*)(agg + ((size_t)((b * 4 + seg) * 512 + cb * 64 + c)) * 2) = (f32x2){Ptot, h};
    __syncthreads();
}

template <bool FINAL>
DI void hgrn_item(LAS unsigned char* lds, const Args& a, int it) {
    const int tid = tid_(), lane = tid & 63, w = tid >> 6, l15 = lane & 15, q4 = lane >> 4;
    const int bh = it >> 3, seg = it & 7, b = bh >> 2, hd = bh & 3;
    const bf16_t* z = (const bf16_t*)(a.ws + WS_Z); bf16_t* mix = (bf16_t*)(a.ws + WS_MIX);
    float* HGS = (float*)(a.ws + WS_HGS); float* HGD = (float*)(a.ws + WS_HGD);
    LAS bf16_t* QS = (LAS bf16_t*)lds;
    LAS bf16_t* KS = QS + 64 * 136;
    LAS bf16_t* KSt = KS + 64 * 136;
    LAS bf16_t* Vt = KSt + 128 * 72;
    LAS bf16_t* Pm = Vt + 128 * 72;
    LAS bf16_t* St = Pm + 64 * 72;
    LAS float* CS = (LAS float*)(St + 128 * 136);
    LAS float* EM = CS + 512; LAS float* EL = EM + 128; LAS float* DEC = EL + 128; LAS float* GN = DEC + 128;
    LAS bf16_t* RV = (LAS bf16_t*)(GN + 128);
    LAS bf16_t* RF = Pm;
    LAS bf16_t* RQ = RF + 64 * 128;
    LAS float* OB = (LAS float*)lds;
    static_assert((64 * 136 * 2 + 128 * 72 * 2 + 64 * 72 + 128 * 136) * 2 + (512 + 128 * 4) * 4 + 64 * 128 * 2 <= 158720, "hgrn lds");
    static_assert(64 * 132 * 4 <= 64 * 136 * 2 * 2 && 2 * 64 * 128 <= 64 * 72 + 128 * 136, "hgrn aliases");
    const int dk = tid & 127, sub = tid >> 7;
    float lbv;
    { const float* lg = a.in[12]; const int col = hd * 128 + dk; const float l0 = lg[col], l1 = lg[512 + col], l2 = lg[1024 + col];
      const float mx = fmaxf(l0, fmaxf(l1, l2)); const float e0 = __expf(l0 - mx), e1 = __expf(l1 - mx), e2 = __expf(l2 - mx); lbv = e0 / (e0 + e1 + e2); }
    if (tid < 128) GN[tid] = a.in[13][tid];
    f32x4 Sacc[8];
#pragma unroll
    for (int nt = 0; nt < 8; ++nt) Sacc[nt] = (f32x4){0.f, 0.f, 0.f, 0.f};
    if (FINAL) for (int j = 0; j < seg; ++j) { const int itj = bh * 8 + j;
#pragma unroll
        for (int nt = 0; nt < 8; ++nt) { const float d = HGD[(size_t)itj * 128 + nt * 16 + l15];
            const f32x4 sj = *(const f32x4*)(HGS + (size_t)itj * 16384 + (size_t)((w * 8 + nt) * 64 + lane) * 4); Sacc[nt] = Sacc[nt] * d + sj; } }
    float dtot = 1.f;
    const size_t tok0 = (size_t)b * TSEQ + seg * 1024;
    const bf16_t* zbase = z + (tok0 + (tid >> 4)) * 3072 + hd * 128 + (tid & 15) * 8;
    const int roff = (tid >> 4) * 128 + (tid & 15) * 8;
    u32x4 pf_f[2], pf_v[2], pf_q[2];
#pragma unroll
    for (int k = 0; k < 2; ++k) { const bf16_t* p = zbase + (size_t)(32 * k) * 3072; pf_f[k] = *(const u32x4*)(p + 1536); pf_v[k] = *(const u32x4*)(p + 2048); if (FINAL) pf_q[k] = *(const u32x4*)(p + 1024); }
#pragma unroll
    for (int k = 0; k < 2; ++k) { *(LAS u32x4*)(RF + roff + k * 4096) = pf_f[k]; *(LAS u32x4*)(RV + roff + k * 4096) = pf_v[k]; if (FINAL) *(LAS u32x4*)(RQ + roff + k * 4096) = pf_q[k]; }
    __syncthreads();
    for (int ck = 0; ck < 16; ++ck) {
        const size_t rowbase = tok0 + ck * 64;
        const bool more = ck + 1 < 16;
        if (more) {
#pragma unroll
            for (int k = 0; k < 2; ++k) { const bf16_t* p = zbase + (size_t)((ck + 1) * 64 + 32 * k) * 3072; pf_f[k] = *(const u32x4*)(p + 1536); pf_v[k] = *(const u32x4*)(p + 2048); if (FINAL) pf_q[k] = *(const u32x4*)(p + 1024); }
        }
        float pf[16], kf[16];
        { float run = 1.f;
#pragma unroll
          for (int i = 0; i < 16; ++i) { const float fl = bf2f(RF[(sub * 16 + i) * 128 + dk]);
              const float f = lbv + (1.0f - lbv) * sigmoidf_(fl); kf[i] = 1.0f - f; run *= f; pf[i] = run; }
          CS[sub * 128 + dk] = run; }
        __syncthreads();
        {
            const float c0 = CS[dk], c1 = CS[128 + dk], c2 = CS[256 + dk], c3 = CS[384 + dk];
            const float offs = (sub > 0 ? c0 : 1.f) * (sub > 1 ? c1 : 1.f) * (sub > 2 ? c2 : 1.f);
            const float pmid = c0 * c1, plast = pmid * c2 * c3; const float rpmid = __builtin_amdgcn_rcpf(pmid);
#pragma unroll
            for (int i = 0; i < 16; ++i) { const int s = sub * 16 + i; const float P = offs * pf[i];
                const bf16_t ks = f2bf(kf[i] * pmid * __builtin_amdgcn_rcpf(P));
                KSt[dk * 72 + s] = ks; Vt[dk * 72 + s] = RV[s * 128 + dk];
                if (FINAL) { KS[s * 136 + dk] = ks; const float q = bf2f(RQ[s * 128 + dk]); QS[s * 136 + dk] = f2bf(q * (P * rpmid)); } }
            if (sub == 0) { EM[dk] = pmid; EL[dk] = c2 * c3; DEC[dk] = plast; }
            dtot *= plast;
        }
        __syncthreads();
        f32x4 oacc[4];
        u32x4 gpre[2];
        if (FINAL) {
#pragma unroll
            for (int nt = 0; nt < 8; ++nt) { const float em = EM[nt * 16 + l15];
#pragma unroll
                for (int j = 0; j < 4; ++j) St[(16 * w + 4 * q4 + j) * 136 + nt * 16 + l15] = f2bf(Sacc[nt][j] * em); }
            { const int mt = w >> 1, n0 = (w & 1) * 2; f32x4 sc0 = (f32x4){0.f, 0.f, 0.f, 0.f}, sc1 = sc0;
#pragma unroll
              for (int k = 0; k < 4; ++k) { const bf16x8 av = *(const LAS bf16x8*)(QS + (mt * 16 + l15) * 136 + k * 32 + 8 * q4);
                  const bf16x8 b0 = *(const LAS bf16x8*)(KS + (n0 * 16 + l15) * 136 + k * 32 + 8 * q4), b1 = *(const LAS bf16x8*)(KS + ((n0 + 1) * 16 + l15) * 136 + k * 32 + 8 * q4);
                  sc0 = __builtin_amdgcn_mfma_f32_16x16x32_bf16(av, b0, sc0, 0, 0, 0); sc1 = __builtin_amdgcn_mfma_f32_16x16x32_bf16(av, b1, sc1, 0, 0, 0); }
#pragma unroll
              for (int j = 0; j < 4; ++j) { const int t = mt * 16 + 4 * q4 + j, s0 = n0 * 16 + l15, s1 = s0 + 16;
                  Pm[t * 72 + s0] = (s0 <= t) ? f2bf(sc0[j]) : (bf16_t)0; Pm[t * 72 + s1] = (s1 <= t) ? f2bf(sc1[j]) : (bf16_t)0; } }
            __syncthreads();
#pragma unroll
            for (int m4 = 0; m4 < 4; ++m4) oacc[m4] = (f32x4){0.f, 0.f, 0.f, 0.f};
#pragma unroll
            for (int k = 0; k < 2; ++k) { const bf16x8 bv = *(const LAS bf16x8*)(Vt + (16 * w + l15) * 72 + k * 32 + 8 * q4);
#pragma unroll
                for (int m4 = 0; m4 < 4; ++m4) { const bf16x8 av = *(const LAS bf16x8*)(Pm + (m4 * 16 + l15) * 72 + k * 32 + 8 * q4); oacc[m4] = __builtin_amdgcn_mfma_f32_16x16x32_bf16(av, bv, oacc[m4], 0, 0, 0); } }
#pragma unroll
            for (int k = 0; k < 4; ++k) { const bf16x8 bv = *(const LAS bf16x8*)(St + (16 * w + l15) * 136 + k * 32 + 8 * q4);
#pragma unroll
                for (int m4 = 0; m4 < 4; ++m4) { const bf16x8 av = *(const LAS bf16x8*)(QS + (m4 * 16 + l15) * 136 + k * 32 + 8 * q4); oacc[m4] = __builtin_amdgcn_mfma_f32_16x16x32_bf16(av, bv, oacc[m4], 0, 0, 0); } }
        } else if (more) {
#pragma unroll
            for (int k = 0; k < 2; ++k) { *(LAS u32x4*)(RF + roff + k * 4096) = pf_f[k]; *(LAS u32x4*)(RV + roff + k * 4096) = pf_v[k]; }
        }
        {
            f32x4 kv[8];
#pragma unroll
            for (int nt = 0; nt < 8; ++nt) kv[nt] = (f32x4){0.f, 0.f, 0.f, 0.f};
#pragma unroll
            for (int k = 0; k < 2; ++k) { const bf16x8 av = *(const LAS bf16x8*)(Vt + (16 * w + l15) * 72 + k * 32 + 8 * q4);
#pragma unroll
                for (int nt = 0; nt < 8; ++nt) { const bf16x8 bv = *(const LAS bf16x8*)(KSt + (nt * 16 + l15) * 72 + k * 32 + 8 * q4); kv[nt] = __builtin_amdgcn_mfma_f32_16x16x32_bf16(av, bv, kv[nt], 0, 0, 0); } }
#pragma unroll
            for (int nt = 0; nt < 8; ++nt) { const float dec = DEC[nt * 16 + l15], el = EL[nt * 16 + l15]; Sacc[nt] = Sacc[nt] * dec + kv[nt] * el; }
        }
        if (FINAL) {
            { const u32x4* gp0 = (const u32x4*)(z + (rowbase + (tid >> 3)) * 3072 + 2560 + hd * 128 + (tid & 7) * 16); gpre[0] = gp0[0]; gpre[1] = gp0[1]; }
            __syncthreads();
#pragma unroll
            for (int m4 = 0; m4 < 4; ++m4)
#pragma unroll
                for (int j = 0; j < 4; ++j) OB[(m4 * 16 + 4 * q4 + j) * 132 + 16 * w + l15] = oacc[m4][j];
            if (more) {
#pragma unroll
                for (int k = 0; k < 2; ++k) { *(LAS u32x4*)(RF + roff + k * 4096) = pf_f[k]; *(LAS u32x4*)(RV + roff + k * 4096) = pf_v[k]; *(LAS u32x4*)(RQ + roff + k * 4096) = pf_q[k]; }
            }
            __syncthreads();
            const int t = tid >> 3, part = tid & 7; const size_t row = rowbase + t;
            f32x4 o[4]; float ss = 0.f;
#pragma unroll
            for (int i = 0; i < 4; ++i) { o[i] = *(const LAS f32x4*)(OB + t * 132 + part * 16 + i * 4); ss += (o[i][0] * o[i][0] + o[i][1] * o[i][1]) + (o[i][2] * o[i][2] + o[i][3] * o[i][3]); }
            ss += __shfl_xor(ss, 1); ss += __shfl_xor(ss, 2); ss += __shfl_xor(ss, 4);
            const float rstd = rsqrtf(ss * (1.0f / 128.0f) + 1e-6f);
            u32x4* op = (u32x4*)(mix + row * 1024 + 512 + hd * 128 + part * 16);
#pragma unroll
            for (int hh = 0; hh < 2; ++hh) { const u32x4 gw = gpre[hh]; u32x4 ow;
#pragma unroll
                for (int e = 0; e < 4; ++e) { const unsigned gword = gw[e]; const int i0 = hh * 8 + e * 2;
                    const float v0 = o[i0 >> 2][i0 & 3] * rstd * GN[part * 16 + i0] * bflo(gword);
                    const float v1 = o[(i0 + 1) >> 2][(i0 + 1) & 3] * rstd * GN[part * 16 + i0 + 1] * bfhi(gword);
                    ow[e] = cvt_pk_bf16(v0, v1); }
                op[hh] = ow; }
        } else {
            __syncthreads();
        }
    }
    if (!FINAL) {
#pragma unroll
        for (int nt = 0; nt < 8; ++nt) *(f32x4*)(HGS + (size_t)it * 16384 + (size_t)((w * 8 + nt) * 64 + lane) * 4) = Sacc[nt];
        if (sub == 0) HGD[(size_t)it * 128 + dk] = dtot;
    }
    __syncthreads();
}

template <bool FINAL> DI void phase_mixer0(LAS unsigned char* lds, const Args& a) {
#ifndef NO_HG
    for (int it = bid_(); it < 256; it += (int)gridDim.x) hgrn_item<FINAL>(lds, a, it);
#endif
#ifndef NO_LRU
    for (int it = bid_(); it < 256; it += (int)gridDim.x) lru_item<FINAL>(lds, a, it);
#endif
}

DI void phase_sgu(LAS unsigned char* lds, const Args& a) {
    const int tid = tid_(), lane = tid & 63, w = tid >> 6, c8 = tid & 15;
    const bf16_t* uv = (const bf16_t*)(a.ws + WS_UV); bf16_t* sg = (bf16_t*)(a.ws + WS_SG); const bf16_t* wsc = (const bf16_t*)(a.ws + WS_WSC); const float* vst = (const float*)(a.ws + WS_VST);
    LAS bf16_t* WC = (LAS bf16_t*)lds;
    LAS bf16_t* VnT = WC + 128 * 136;
    LAS float* MU = (LAS float*)(VnT + 128 * 136); LAS float* RS = MU + 128;
    LAS float* OT = (LAS float*)(lds + 70656);
    const int G = (int)gridDim.x;
    int cur_g = -1; float lg[8], lb8[8];
#pragma unroll
    for (int e = 0; e < 8; ++e) { lg[e] = 0.f; lb8[e] = 0.f; }
    u32x4 raw[4]; float mu_r = 0.f, rs_r = 0.f;
    int it = bid_();
    if (it < 4096) { const size_t rb = (size_t)(it >> 3) * 128; const int g = it & 7;
#pragma unroll
        for (int i = 0; i < 4; ++i) raw[i] = *(const u32x4*)(uv + (rb + (tid >> 4) + 32 * i) * 2048 + 1024 + g * 128 + c8 * 8);
        if (tid < 128) { const size_t row = rb + tid; float s1 = 0.f, s2 = 0.f;
#pragma unroll
            for (int p = 0; p < 16; ++p) { const f32x2 q = *(const f32x2*)(vst + (row * 16 + p) * 2); s1 += q[0]; s2 += q[1]; }
            mu_r = s1 * (1.0f / 1024.0f); rs_r = rsqrtf(fmaxf(s2 * (1.0f / 1024.0f) - mu_r * mu_r, 0.f) + 1e-6f); } }
    for (; it < 4096; it += G) {
        const int g = it & 7; const size_t rowbase = (size_t)(it >> 3) * 128;
        if (g != cur_g) { cur_g = g;
#pragma unroll
            for (int r = 0; r < 4; ++r) { const int e = tid + 512 * r, t = e >> 4, ch = e & 15; *(LAS u32x4*)(WC + t * 136 + ch * 8) = *(const u32x4*)(wsc + g * 16384 + t * 128 + ch * 8); }
#pragma unroll
            for (int e = 0; e < 8; ++e) { lg[e] = a.in[17][g * 128 + c8 * 8 + e]; lb8[e] = a.in[18][g * 128 + c8 * 8 + e]; } }
        if (tid < 128) { MU[tid] = mu_r; RS[tid] = rs_r; }
        u32x4 cur[4];
#pragma unroll
        for (int i = 0; i < 4; ++i) cur[i] = raw[i];
        __syncthreads();
        { const int nit = it + G;
          if (nit < 4096) { const size_t rb = (size_t)(nit >> 3) * 128; const int gn = nit & 7;
#pragma unroll
              for (int i = 0; i < 4; ++i) raw[i] = *(const u32x4*)(uv + (rb + (tid >> 4) + 32 * i) * 2048 + 1024 + gn * 128 + c8 * 8);
              if (tid < 128) { const size_t row = rb + tid; float s1 = 0.f, s2 = 0.f;
#pragma unroll
                  for (int p = 0; p < 16; ++p) { const f32x2 q = *(const f32x2*)(vst + (row * 16 + p) * 2); s1 += q[0]; s2 += q[1]; }
                  mu_r = s1 * (1.0f / 1024.0f); rs_r = rsqrtf(fmaxf(s2 * (1.0f / 1024.0f) - mu_r * mu_r, 0.f) + 1e-6f); } } }
        u32x4 uq[4];
#pragma unroll
        for (int i = 0; i < 4; ++i) uq[i] = *(const u32x4*)(uv + (rowbase + 16 * w + (lane >> 4) + 4 * i) * 2048 + g * 128 + (lane & 15) * 8);
#pragma unroll
        for (int i = 0; i < 4; ++i) { const int s = (tid >> 4) + 32 * i; const u32x4 rw = cur[i];
            const float mu = MU[s], rs = RS[s];
#pragma unroll
            for (int e = 0; e < 4; ++e) { const float v0 = (bflo(rw[e]) - mu) * rs * lg[2 * e] + lb8[2 * e], v1 = (bfhi(rw[e]) - mu) * rs * lg[2 * e + 1] + lb8[2 * e + 1];
                VnT[(c8 * 8 + 2 * e) * 136 + s] = f2bf(v0); VnT[(c8 * 8 + 2 * e + 1) * 136 + s] = f2bf(v1); } }
        __syncthreads();
        f32x4 acc[8];
#pragma unroll
        for (int nt = 0; nt < 8; ++nt) acc[nt] = (f32x4){0.f, 0.f, 0.f, 0.f};
#pragma unroll
        for (int k = 0; k < 4; ++k) { const bf16x8 av = *(const LAS bf16x8*)(WC + (16 * w + (lane & 15)) * 136 + k * 32 + 8 * (lane >> 4));
#pragma unroll
            for (int nt = 0; nt < 8; ++nt) { const bf16x8 bv = *(const LAS bf16x8*)(VnT + (nt * 16 + (lane & 15)) * 136 + k * 32 + 8 * (lane >> 4));
                acc[nt] = __builtin_amdgcn_mfma_f32_16x16x32_bf16(av, bv, acc[nt], 0, 0, 0); } }
#pragma unroll
        for (int nt = 0; nt < 8; ++nt)
#pragma unroll
            for (int j = 0; j < 4; ++j) OT[(16 * w + 4 * (lane >> 4) + j) * 132 + nt * 16 + (lane & 15)] = acc[nt][j];
        asm volatile("s_waitcnt lgkmcnt(0)" ::: "memory");
#pragma unroll
        for (int i = 0; i < 4; ++i) { const int tl = 16 * w + (lane >> 4) + 4 * i; const float bias = a.in[20][g * 128 + tl];
            const f32x4 o0 = *(const LAS f32x4*)(OT + tl * 132 + (lane & 15) * 8), o1 = *(const LAS f32x4*)(OT + tl * 132 + (lane & 15) * 8 + 4);
            const u32x4 uu = uq[i]; u32x4 ow;
            ow.x = cvt_pk_bf16(bflo(uu.x) * (o0[0] + bias), bfhi(uu.x) * (o0[1] + bias)); ow.y = cvt_pk_bf16(bflo(uu.y) * (o0[2] + bias), bfhi(uu.y) * (o0[3] + bias));
            ow.z = cvt_pk_bf16(bflo(uu.z) * (o1[0] + bias), bfhi(uu.z) * (o1[1] + bias)); ow.w = cvt_pk_bf16(bflo(uu.w) * (o1[2] + bias), bfhi(uu.w) * (o1[3] + bias));
            *(u32x4*)(sg + (rowbase + tl) * 1024 + g * 128 + (lane & 15) * 8) = ow; }
        __syncthreads();
    }
}

DI void phase_final(const Args& a) {
    const int tid = tid_(), lane = tid & 63, wave = tid >> 6;
    const int gw = bid_() * 8 + wave, NGW = (int)gridDim.x * 8;
    const float* ssq = (const float*)(a.ws + WS_SSQ); const float* gn = a.in[3]; const bf16_t* hb = (const bf16_t*)(a.ws + WS_HB);
    f32x4 gv[4];
#pragma unroll
    for (int j = 0; j < 4; ++j) gv[j] = *((const f32x4*)gn + lane + 64 * j);
    for (int m = gw; m < MTOK; m += NGW) {
        const float rs = ssq_rs(ssq, (size_t)m);
        const u32x2* hp = (const u32x2*)(hb + (size_t)m * DM) + lane; f32x4* p = (f32x4*)(a.out + (size_t)m * DM) + lane;
#pragma unroll
        for (int j = 0; j < 4; ++j) { const u32x2 r = hp[64 * j]; const f32x4 v = (f32x4){bflo(r.x), bfhi(r.x), bflo(r.y), bfhi(r.y)}; p[64 * j] = v * rs * gv[j]; }
    }
}

#define XB_TMO      128
#define XB_XCNT(j)  (256  + 64 * (j))
#define XB_XSUB(j)  (1280 + 64 * (j))
#define XB_XGEN(j)  (2304 + 64 * (j))
#define XB_TOP      3328
#define XB_TOPGEN   3392
#define XCD_BAR_WORDS 3456
#define XB_SPIN_CAP (1u << 22)
DI unsigned xb_ld(unsigned* p)              { return __hip_atomic_load(p, __ATOMIC_RELAXED, __HIP_MEMORY_SCOPE_AGENT); }
DI unsigned xb_add(unsigned* p, unsigned v) { return __hip_atomic_fetch_add(p, v, __ATOMIC_RELAXED, __HIP_MEMORY_SCOPE_AGENT); }
DI unsigned xb_xcc_id() { return (unsigned)__builtin_amdgcn_s_getreg((3 << 11) | 20) & 0xFu; }
#define XB_SPIN(cond, bar) do { unsigned _sp = 0; while (cond) { __builtin_amdgcn_s_sleep(1); \
    if ((++_sp & 255u) == 0u) { if (xb_ld(&(bar)[XB_TMO])) break; if (_sp > XB_SPIN_CAP) { atomicAdd(&(bar)[XB_TMO], 1u); break; } } } } while (0)
struct XcdBarrier { unsigned* bar; unsigned x; volatile LAS unsigned* st; };
DI XcdBarrier xcd_barrier_post(unsigned* bar, volatile LAS unsigned* st) {
    XcdBarrier b; b.bar = bar; b.x = xb_xcc_id(); b.st = st;
    if (threadIdx.x == 0) (void)xb_add(&bar[XB_XCNT(b.x)], 1u);
    return b;
}
DI void xcd_barrier_complete(unsigned* bar, unsigned x, unsigned& nloc, unsigned& nx) {
    const unsigned G = gridDim.x * gridDim.y * gridDim.z;
    unsigned sum, cnt, mine, sp = 0u;
    for (;;) {
        sum = 0u; cnt = 0u; mine = 0u;
#pragma unroll
        for (unsigned j = 0; j < 16; ++j) { const unsigned c = xb_ld(&bar[XB_XCNT(j)]); sum += c; cnt += (c > 0u) ? 1u : 0u; mine = (j == x) ? c : mine; }
        if (sum == G) break;
        __builtin_amdgcn_s_sleep(1);
        if ((++sp & 255u) == 0u) { if (xb_ld(&bar[XB_TMO])) break; if (sp > XB_SPIN_CAP) { atomicAdd(&bar[XB_TMO], 1u); break; } }
    }
    nloc = mine > 0u ? mine : 1u; nx = cnt > 0u ? cnt : 1u;
}
DI void xcd_barrier(const XcdBarrier& b) {
    asm volatile("s_waitcnt vmcnt(0)" ::: "memory");
    __syncthreads();
    if (threadIdx.x == 0) {
        unsigned* bar = b.bar;
        __builtin_amdgcn_s_waitcnt(0);
        unsigned nloc = b.st[0], nx = b.st[1];
        if (nloc == 0u) { xcd_barrier_complete(bar, b.x, nloc, nx); b.st[0] = nloc; b.st[1] = nx; }
        const unsigned old = xb_add(&bar[XB_XSUB(b.x)], 1u);
        const unsigned gen = old / nloc;
        if (old + 1u == (gen + 1u) * nloc) {
            __builtin_amdgcn_fence(__ATOMIC_RELEASE, "agent");
            asm volatile("s_waitcnt vmcnt(0)" ::: "memory");
            const unsigned og = xb_add(&bar[XB_TOP], 1u);
            const unsigned tg = og / nx;
            if (og + 1u == (tg + 1u) * nx) xb_add(&bar[XB_TOPGEN], 1u);
            else XB_SPIN(xb_ld(&bar[XB_TOPGEN]) == tg, bar);
            __builtin_amdgcn_fence(__ATOMIC_ACQUIRE, "agent");
            xb_add(&bar[XB_XGEN(b.x)], 1u);
            asm volatile("s_waitcnt vmcnt(0)" ::: "memory");
        } else {
            XB_SPIN(xb_ld(&bar[XB_XGEN(b.x)]) == gen, bar);
            __builtin_amdgcn_fence(__ATOMIC_ACQUIRE, "agent");
            asm volatile("s_waitcnt vmcnt(0)" ::: "memory");
        }
    }
    __syncthreads();
}

constexpr int NPHASE = 13;
#ifndef REP_MASK
#define REP_MASK 0
#endif
#ifndef USE_CG_SYNC
#define USE_CG_SYNC 0
#endif
#ifndef PH_MASK
#define PH_MASK 0xFFFF
#endif
#define PHM(k) (((PH_MASK) >> (k)) & 1)
__global__ void __launch_bounds__(NTHR, 2) mk_fwd(Args a) {
    extern __shared__ __attribute__((aligned(16))) unsigned char lds_raw[];
    LAS unsigned char* lds = (LAS unsigned char*)lds_raw;
    unsigned char* ws = a.ws;
    bf16_t* hb = (bf16_t*)(ws + WS_HB); float* ssq = (float*)(ws + WS_SSQ); float* H = a.out;
    volatile LAS unsigned* bst = (volatile LAS unsigned*)(lds + 131072 + 4096 + 23552);
    if (threadIdx.x < 4) bst[threadIdx.x] = 0u;
    __syncthreads();
    XcdBarrier xb = xcd_barrier_post((unsigned*)ws, bst);
    if (threadIdx.x == 0) { const unsigned xcc = xb.x & 7u; bst[2] = xcc; bst[3] = xb_add((unsigned*)ws + 4096 + 64 * xcc, 1u); }
    int vc = (int)blockIdx.x; bool vc_done = false;
    for (int pi = a.ph_lo; pi < a.ph_hi; ++pi) {
        const int ph = a.seq[pi];
        if (pi > 0 && !vc_done) {
            if (threadIdx.x == 0) { bool ok = (gridDim.x % 8u) == 0u;
                for (unsigned j = 0; j < 8; ++j) ok = ok && (xb_ld((unsigned*)ws + 4096 + 64 * j) == gridDim.x / 8u);
                bst[2] = ok ? (bst[2] + 8u * bst[3]) : blockIdx.x; }
            __syncthreads(); vc = __builtin_amdgcn_readfirstlane((int)bst[2]); vc_done = true;
        }
        if (PHM(0) && ph == 0) phase_prep(lds, a);
        else if (PHM(1) && ph == 1) { EpiScale E{(bf16_t*)(ws + WS_Z), 3072, (const LAS float*)(lds + RST_OFF)}; run_gemm<EpiScale, true>(lds, vc, hb, (const bf16_t*)(ws + WS_WIN0), MTOK, 3072, 1024, E, ssq); }
        else if (PHM(2) && ph == 2) phase_mixer0<false>(lds, a);
        else if (PHM(3) && ph == 3) phase_mixer0<true>(lds, a);
        else if (PHM(4) && (ph == 4 || ph == 9)) {
            EpiRes E{hb, ssq};
            run_gemm(lds, vc, (const bf16_t*)(ws + (ph == 4 ? WS_MIX : WS_SG)), (const bf16_t*)(ws + (ph == 4 ? WS_WOUT0 : WS_WOUT1)), MTOK, 1024, 1024, E);
        }
        else if (PHM(5) && ph == 7) { EpiGelu E{(bf16_t*)(ws + WS_UV), 2048, (const LAS float*)(lds + RST_OFF), a.in[16], (float*)(ws + WS_VST)}; run_gemm(lds, vc, hb, (const bf16_t*)(ws + WS_WIN1), MTOK, 2048, 1024, E, ssq); }
        else if (PHM(6) && ph == 8) phase_sgu(lds, a);
        else if (PHM(7) && ph == 12) phase_final(a);
        else if (PHM(8) && (ph == 5 || ph == 10)) {
            const int layer = (ph == 10);
            EpiFfn E{(bf16_t*)(ws + WS_ACT), (const LAS float*)(lds + RST_OFF), a.in[23] + (size_t)layer * 3 * DFF, a.in[24] + (size_t)layer * DFF, (LAS float*)(lds + 131072)};
            run_gemm_ffn(lds, vc, hb, (const bf16_t*)(ws + (layer ? WS_WUP1 : WS_WUP0)), ssq, E);
        }
        else if (PHM(9) && (ph == 6 || ph == 11)) {
            const int layer = (ph == 11);
            EpiRes E{hb, ssq}; run_gemm(lds, vc, (const bf16_t*)(ws + WS_ACT), (const bf16_t*)(ws + (layer ? WS_WDN1 : WS_WDN0)), MTOK, 1024, DFF, E);
        }
        if (pi + 1 < a.ph_hi) {
            if (USE_CG_SYNC || a.ph_hi > 1000) { __threadfence(); cg::this_grid().sync(); }
            else xcd_barrier(xb);
        }
    }
}

extern "C" void kernel_launch(void* const* d_in, const int* in_sizes, int n_in, void* d_out, int out_size, void* d_ws, size_t ws_size, hipStream_t stream) {
    static int grid = 0;
    if (grid == 0) {
        if (n_in != 26 || ws_size < WS_END) { fprintf(stderr, "kernel_launch: unexpected n_in %d / ws_size %zu (need %zu)\n", n_in, ws_size, (size_t)WS_END); grid = -1; return; }
        int dev = 0, cus = 0, per_cu = 0;
        (void)hipGetDevice(&dev); (void)hipDeviceGetAttribute(&cus, hipDeviceAttributeMultiprocessorCount, dev);
        if (hipFuncSetAttribute((const void*)mk_fwd, hipFuncAttributeMaxDynamicSharedMemorySize, LDS_BYTES) != hipSuccess) { fprintf(stderr, "kernel_launch: hipFuncSetAttribute failed\n"); grid = -1; return; }
        if (hipOccupancyMaxActiveBlocksPerMultiprocessor(&per_cu, (const void*)mk_fwd, NTHR, LDS_BYTES) != hipSuccess || per_cu < 1) { fprintf(stderr, "kernel_launch: occupancy query gave %d\n", per_cu); per_cu = 1; }
        (void)hipGetLastError();
        grid = cus * per_cu;
    }
    if (grid < 0) return;
    Args a{};
    for (int i = 0; i < 26; ++i) a.in[i] = (const float*)d_in[i];
    a.out = (float*)d_out; a.ws = (unsigned char*)d_ws;
#if ONE_LAUNCH
    { int n = 0; for (int ph = 0; ph < NPHASE; ++ph) { a.seq[n++] = ph; if ((REP_MASK >> ph) & 1) a.seq[n++] = ph; } a.ph_lo = 0; a.ph_hi = n; }
    if (hipMemsetAsync(d_ws, 0, 32768, stream) != hipSuccess) { fprintf(stderr, "kernel_launch: memset of the barrier words failed\n"); return; }
    void* args[] = {&a};
    hipError_t e = hipLaunchCooperativeKernel((const void*)mk_fwd, dim3(grid), dim3(NTHR), args, LDS_BYTES, stream);
    if (e != hipSuccess) fprintf(stderr, "cooperative launch failed: %s (grid %d)\n", hipGetErrorString(e), grid);
#else
    for (int ph = 0; ph < NPHASE; ++ph) {
        a.seq[0] = ph; a.ph_lo = 0; a.ph_hi = 1;
        hipLaunchKernelGGL(mk_fwd, dim3(grid), dim3(NTHR), LDS_BYTES, stream, a);
    }
#endif
}
```

```cpp
#include <hip/hip_runtime.h>
#include <hip/hip_cooperative_groups.h>
#include <cstdio>
namespace cg = cooperative_groups;

#ifndef ONE_LAUNCH
#define ONE_LAUNCH 1
#endif

#define LAS __attribute__((address_space(3)))
#define DI __device__ __forceinline__
typedef unsigned short bf16_t;
typedef short bf16x8 __attribute__((ext_vector_type(8)));
typedef float f32x4 __attribute__((ext_vector_type(4)));
typedef float f32x2 __attribute__((ext_vector_type(2)));
typedef unsigned u32x4 __attribute__((ext_vector_type(4)));
typedef unsigned u32x2 __attribute__((ext_vector_type(2)));

constexpr int MTOK = 65536, DM = 1024, TSEQ = 8192, NBATCH = 8, DFF = 2816;
constexpr int LDS_BYTES = 131072 + 4096 + 23552 + 16;
constexpr int NTHR = 512;

constexpr size_t MiB = 1024ull * 1024ull;
constexpr size_t WS_WIN0 = 1 * MiB;
constexpr size_t WS_WOUT0 = WS_WIN0 + 6 * MiB;
constexpr size_t WS_WUP0 = WS_WOUT0 + 2 * MiB;
constexpr size_t WS_WDN0 = WS_WUP0 + 11 * MiB;
constexpr size_t WS_WIN1 = WS_WDN0 + 11 * MiB / 2;
constexpr size_t WS_WOUT1 = WS_WIN1 + 4 * MiB;
constexpr size_t WS_WUP1 = WS_WOUT1 + 2 * MiB;
constexpr size_t WS_WDN1 = WS_WUP1 + 11 * MiB;
constexpr size_t WS_WSC = 48 * MiB;
constexpr size_t WS_SSQ = 49 * MiB;
constexpr size_t WS_VST = 53 * MiB;
constexpr size_t WS_LRUAGG = 61 * MiB;
constexpr size_t WS_HGD = 62 * MiB;
constexpr size_t WS_HGS = 63 * MiB;
constexpr size_t WS_HB = 80 * MiB;
constexpr size_t WS_R1 = 208 * MiB;
constexpr size_t WS_Z = WS_R1;
constexpr size_t WS_MIX = WS_R1 + 384 * MiB;
constexpr size_t WS_ACT = WS_R1;
constexpr size_t WS_UV = WS_R1;
constexpr size_t WS_SG = WS_R1 + 384 * MiB;
constexpr size_t WS_END = WS_R1 + 528 * MiB;

struct Args { const float* in[26]; float* out; unsigned char* ws; int ph_lo, ph_hi; int seq[32]; };

typedef __bf16 bf16x2_t __attribute__((ext_vector_type(2)));
DI unsigned cvt_pk_bf16(float lo, float hi) { const bf16x2_t v = __builtin_convertvector((f32x2){lo, hi}, bf16x2_t); return __builtin_bit_cast(unsigned, v); }
DI bf16_t f2bf(float f) { return (bf16_t)(cvt_pk_bf16(f, 0.f) & 0xffffu); }
DI float bf2f(bf16_t b) { return __builtin_bit_cast(float, (unsigned)b << 16); }
DI float bflo(unsigned w) { return __builtin_bit_cast(float, w << 16); }
DI float bfhi(unsigned w) { return __builtin_bit_cast(float, w & 0xffff0000u); }
DI int tid_() { int t = (int)threadIdx.x; asm volatile("" : "+v"(t)); return t; }
DI int bid_() { int b = __builtin_amdgcn_workgroup_id_x(); asm volatile("" : "+s"(b)); return b; }
DI float sigmoidf_(float x) { return __builtin_amdgcn_rcpf(1.0f + __builtin_amdgcn_exp2f(x * -1.44269504f)); }
DI float siluf_(float x) { return x * sigmoidf_(x); }
DI float geluf_(float x) { const float y = 1.5957691216f * (x + 0.044715f * x * x * x); return x * sigmoidf_(y); }
DI float wave_sum(float v) {
#pragma unroll
    for (int o = 1; o < 64; o <<= 1) v += __shfl_xor(v, o);
    return v;
}
DI f32x4 mma16(const LAS bf16_t* A, int lda, const LAS bf16_t* Bt, int ldb, int K, f32x4 acc, int lane) {
    const LAS bf16_t* a = A + (lane & 15) * lda + 8 * (lane >> 4);
    const LAS bf16_t* b = Bt + (lane & 15) * ldb + 8 * (lane >> 4);
#pragma unroll
    for (int k = 0; k < K; k += 32) {
        const bf16x8 av = *(const LAS bf16x8*)(a + k); const bf16x8 bv = *(const LAS bf16x8*)(b + k);
        acc = __builtin_amdgcn_mfma_f32_16x16x32_bf16(av, bv, acc, 0, 0, 0);
    }
    return acc;
}

namespace pg8 {
constexpr int BM = 256, BK = 64, HALF = 128, HTB = HALF * BK * 2, STAGE_BYTES = 8 * HTB, NXCD = 8, WGM = 8;
DI int lds_byte(int r, int c) { const int st = (r >> 4) * 2 + (c >> 5), rr = r & 15, cc = c & 31, ob = rr * 64 + cc * 2; return st * 1024 + (ob ^ (((ob >> 9) & 1) << 5)); }
DI void stage_rc(int b, int& R, int& C) { const int st = b / 1024, sb = b % 1024, swz = sb ^ (((sb >> 9) & 1) << 5); R = (st >> 1) * 16 + swz / 64; C = (st & 1) * 32 + (swz % 64) / 2; }
DI int perm32(int rho) { const int n = rho >> 4, i = rho & 15; return 8 * (i >> 2) + 4 * n + (i & 3); }
struct Unit { int pm, pn, arow, ord; };
struct Gemm { const bf16_t* A; const bf16_t* Bt; int M, N, K; };
struct StaticOrder {
    int nM, nN, nwg, G, c, ffn;
    DI void init(int M, int N, int G_, int c_) { nM = M / BM; nN = N / BM; nwg = nM * nN; G = G_; c = c_; ffn = 0; }
    DI void init_ffn(int G_, int c_) { nM = 264; nN = 22; nwg = nM * nN; G = G_; c = c_; ffn = 1; }
    DI bool next(int i, Unit& u) const {
        const long L = (long)i * G + c; if (L >= nwg) return false;
        int wgid = (int)L; { const int q = nwg / NXCD, r = nwg % NXCD, xcd = wgid % NXCD, off = wgid / NXCD; wgid = (xcd < r ? xcd * (q + 1) : r * (q + 1) + (xcd - r) * q) + off; }
        const int nig = WGM * nN, gid = wgid / nig, fm = gid * WGM, gsz = (nM - fm) < WGM ? (nM - fm) : WGM;
        u.pm = fm + ((wgid % nig) % gsz); u.pn = (wgid % nig) / gsz;
        if (ffn) { const int bb = u.pm / 33, ii = u.pm - bb * 33; u.arow = bb * 8192 + ii * 254 - 2; } else u.arow = u.pm * BM;
        return true;
    }
};

template <class Epi>
DI void gemm_phase(LAS unsigned char* lds, const Gemm g, const StaticOrder& S, const Epi& E) {
    const int tid = tid_(), wid = __builtin_amdgcn_readfirstlane(tid >> 6), lane = tid & 63, wr = wid >> 2, wc = wid & 3, fr = lane & 15, fq = lane >> 4;
    const int K = g.K, nt = K / BK;
    unsigned voffA[2], voffB[2];
#pragma unroll
    for (int i = 0; i < 2; ++i) { int R, C; stage_rc(tid * 16 + i * 8192, R, C); const int Rb = Epi::PERM ? ((R & ~31) + perm32(R & 31)) : R;
        voffA[i] = (unsigned)(R * K + C) * 2u; voffB[i] = (unsigned)(Rb * K + C) * 2u; }
    const size_t kstep = (size_t)(BK * 2);
    const size_t hstep = (size_t)HALF * K * 2;
    const size_t tstep = 2 * hstep;
    const unsigned ldsw = (unsigned)wid * 1024u;
    const int aoff = lds_byte(wr * 64 + fr, fq * 8), boff = lds_byte(wc * 32 + fr, fq * 8);
#define PG8_SA(b, h) (((b) * 2 + (h)) * HTB)
#define PG8_SB(b, h) ((4 + (b) * 2 + (h)) * HTB)
#define PG8_STAGE(bufoff, gbase, voff) do { _Pragma("unroll") for (int _i = 0; _i < 2; ++_i) \
        __builtin_amdgcn_global_load_lds((const unsigned*)((const char*)(gbase) + (voff)[_i]), (LAS unsigned*)(lds + (bufoff) + ldsw + _i * 8192), 16, 0, 0); } while (0)
#define PG8_LDA(dst, b, h) do { _Pragma("unroll") for (int m = 0; m < 4; ++m) _Pragma("unroll") for (int k = 0; k < 2; ++k) dst[m][k] = *(const LAS bf16x8*)(lds + PG8_SA(b, h) + aoff + m * 2048 + k * 1024); } while (0)
#define PG8_LDB(dst, b, h) do { _Pragma("unroll") for (int n = 0; n < 2; ++n) _Pragma("unroll") for (int k = 0; k < 2; ++k) dst[n][k] = *(const LAS bf16x8*)(lds + PG8_SB(b, h) + boff + n * 2048 + k * 1024); } while (0)
#define PG8_MMA(ai, bj, At, Bt) do { __builtin_amdgcn_s_setprio(1); _Pragma("unroll") for (int m = 0; m < 4; ++m) _Pragma("unroll") for (int n = 0; n < 2; ++n) _Pragma("unroll") for (int k = 0; k < 2; ++k) \
        acc[ai][bj][m][n] = __builtin_amdgcn_mfma_f32_16x16x32_bf16(Bt[n][k], At[m][k], acc[ai][bj][m][n], 0, 0, 0); __builtin_amdgcn_s_setprio(0); } while (0)
#define PG8_WAIT_V(n) asm volatile("s_waitcnt vmcnt(" #n ")" ::: "memory")
#define PG8_WAIT_L(n) asm volatile("s_waitcnt lgkmcnt(" #n ")" ::: "memory")
#define PG8_BAR __builtin_amdgcn_s_barrier()
#define PG8_SCHED __builtin_amdgcn_sched_barrier(0)
    Unit cur, nxt; nxt.pm = 0; nxt.pn = 0; nxt.arow = 0; nxt.ord = 0; int ui = 0;
    if (!S.next(0, cur)) return;
    cur.ord = 0;
    f32x4 acc[2][2][4][2];
#pragma unroll
    for (int a = 0; a < 2; ++a)
#pragma unroll
        for (int b = 0; b < 2; ++b)
#pragma unroll
            for (int m = 0; m < 4; ++m)
#pragma unroll
                for (int n = 0; n < 2; ++n) acc[a][b][m][n] = (f32x4){0.f, 0.f, 0.f, 0.f};
    bf16x8 At[4][2], B0[2][2], B1[2][2];
    const char* cA = (const char*)g.A + (ptrdiff_t)cur.arow * (ptrdiff_t)(K * 2); const char* cB = (const char*)g.Bt + (size_t)cur.pn * tstep;
    PG8_STAGE(PG8_SB(0, 0), cB, voffB); PG8_STAGE(PG8_SA(0, 0), cA, voffA); PG8_STAGE(PG8_SB(0, 1), cB + hstep, voffB); PG8_STAGE(PG8_SA(0, 1), cA + hstep, voffA);
    if (wr == 1) PG8_BAR;
    PG8_WAIT_V(4); PG8_BAR;
    PG8_STAGE(PG8_SB(1, 0), cB + kstep, voffB); PG8_STAGE(PG8_SA(1, 0), cA + kstep, voffA); PG8_STAGE(PG8_SB(1, 1), cB + hstep + kstep, voffB);
    PG8_WAIT_V(6); PG8_BAR;
    for (;;) {
        const bool has_next = S.next(ui + 1, nxt); nxt.ord = ui + 1;
        const char* nA = has_next ? (const char*)g.A + (ptrdiff_t)nxt.arow * (ptrdiff_t)(K * 2) : cA; const char* nB = has_next ? (const char*)g.Bt + (size_t)nxt.pn * tstep : cB;
        for (int t = 0; t < nt; t += 2) {
            const bool last = (t == nt - 2);
            const char* a1 = cA + (size_t)(t + 1) * kstep;
            const char* a2 = last ? nA : cA + (size_t)(t + 2) * kstep; const char* b2 = last ? nB : cB + (size_t)(t + 2) * kstep;
            const char* a3 = a2 + kstep; const char* b3 = b2 + kstep;
            PG8_LDB(B0, 0, 0); PG8_SCHED; PG8_LDA(At, 0, 0); PG8_STAGE(PG8_SA(1, 1), a1 + hstep, voffA);
            PG8_WAIT_L(8); PG8_BAR; PG8_WAIT_L(0); PG8_MMA(0, 0, At, B0); PG8_BAR; PG8_SCHED;
            PG8_LDB(B1, 0, 1); PG8_STAGE(PG8_SB(0, 0), b2, voffB);
            PG8_BAR; PG8_WAIT_L(0); PG8_MMA(0, 1, At, B1); PG8_BAR;
            PG8_LDA(At, 0, 1); PG8_STAGE(PG8_SA(0, 0), a2, voffA);
            PG8_BAR; PG8_WAIT_L(0); PG8_MMA(1, 0, At, B0); PG8_BAR; PG8_SCHED;
            PG8_STAGE(PG8_SB(0, 1), b2 + hstep, voffB);
            PG8_WAIT_V(6); PG8_BAR; PG8_MMA(1, 1, At, B1); PG8_BAR;
            PG8_LDB(B0, 1, 0); PG8_SCHED; PG8_LDA(At, 1, 0); PG8_STAGE(PG8_SA(0, 1), a2 + hstep, voffA);
            PG8_WAIT_L(8); PG8_BAR; PG8_WAIT_L(0); PG8_MMA(0, 0, At, B0); PG8_BAR; PG8_SCHED;
            PG8_LDB(B1, 1, 1); PG8_STAGE(PG8_SB(1, 0), b3, voffB);
            PG8_BAR; PG8_WAIT_L(0); PG8_MMA(0, 1, At, B1); PG8_BAR;
            PG8_LDA(At, 1, 1); PG8_STAGE(PG8_SA(1, 0), a3, voffA);
            PG8_BAR; PG8_WAIT_L(0); PG8_MMA(1, 0, At, B0); PG8_BAR; PG8_SCHED;
            PG8_STAGE(PG8_SB(1, 1), b3 + hstep, voffB);
            PG8_WAIT_V(6); PG8_BAR; PG8_MMA(1, 1, At, B1); PG8_BAR;
        }
        E(acc, cur, wr, wc, fr, fq);
        if (!has_next) break;
#pragma unroll
        for (int a = 0; a < 2; ++a)
#pragma unroll
            for (int b = 0; b < 2; ++b)
#pragma unroll
                for (int m = 0; m < 4; ++m)
#pragma unroll
                    for (int n = 0; n < 2; ++n) acc[a][b][m][n] = (f32x4){0.f, 0.f, 0.f, 0.f};
        cur = nxt; cA = nA; cB = nB; ++ui;
    }
    PG8_WAIT_V(0);
    if (wr == 0) PG8_BAR;
    PG8_BAR;
#undef PG8_SA
#undef PG8_SB
#undef PG8_STAGE
#undef PG8_LDA
#undef PG8_LDB
#undef PG8_MMA
#undef PG8_WAIT_V
#undef PG8_WAIT_L
#undef PG8_BAR
#undef PG8_SCHED
}
template <class Epi>
DI void gemm_phase4(LAS unsigned char* lds, const Gemm g, const StaticOrder& S, const Epi& E) {
    const int tid = tid_(), wid = __builtin_amdgcn_readfirstlane(tid >> 6), lane = tid & 63, wr = wid >> 2, wc = wid & 3, fr = lane & 15, fq = lane >> 4;
    const int K = g.K, nt = K / BK;
    unsigned voffA[2], voffB[2];
#pragma unroll
    for (int i = 0; i < 2; ++i) { int R, C; stage_rc(tid * 16 + i * 8192, R, C); const int Rb = Epi::PERM ? ((R & ~31) + perm32(R & 31)) : R;
        voffA[i] = (unsigned)(R * K + C) * 2u; voffB[i] = (unsigned)(Rb * K + C) * 2u; }
    const size_t kstep = (size_t)(BK * 2);
    const size_t hstep = (size_t)HALF * K * 2;
    const size_t tstep = 2 * hstep;
    const unsigned ldsw = (unsigned)wid * 1024u;
    const int aoff = lds_byte(wr * 64 + fr, fq * 8), boff = lds_byte(wc * 32 + fr, fq * 8);
#define PG8_SA(b, h) (((b) * 2 + (h)) * HTB)
#define PG8_SB(b, h) ((4 + (b) * 2 + (h)) * HTB)
#define PG8_STAGE(bufoff, gbase, voff) do { _Pragma("unroll") for (int _i = 0; _i < 2; ++_i) \
        __builtin_amdgcn_global_load_lds((const unsigned*)((const char*)(gbase) + (voff)[_i]), (LAS unsigned*)(lds + (bufoff) + ldsw + _i * 8192), 16, 0, 0); } while (0)
#define PG8_LDA(dst, b, h) do { _Pragma("unroll") for (int m = 0; m < 4; ++m) _Pragma("unroll") for (int k = 0; k < 2; ++k) dst[m][k] = *(const LAS bf16x8*)(lds + PG8_SA(b, h) + aoff + m * 2048 + k * 1024); } while (0)
#define PG8_LDB(dst, b, h) do { _Pragma("unroll") for (int n = 0; n < 2; ++n) _Pragma("unroll") for (int k = 0; k < 2; ++k) dst[n][k] = *(const LAS bf16x8*)(lds + PG8_SB(b, h) + boff + n * 2048 + k * 1024); } while (0)
#define PG8_MMA(ai, bj, At, Bt) do { __builtin_amdgcn_s_setprio(1); _Pragma("unroll") for (int m = 0; m < 4; ++m) _Pragma("unroll") for (int n = 0; n < 2; ++n) _Pragma("unroll") for (int k = 0; k < 2; ++k) \
        acc[ai][bj][m][n] = __builtin_amdgcn_mfma_f32_16x16x32_bf16(Bt[n][k], At[m][k], acc[ai][bj][m][n], 0, 0, 0); __builtin_amdgcn_s_setprio(0); } while (0)
#define PG8_WAIT_V(n) asm volatile("s_waitcnt vmcnt(" #n ")" ::: "memory")
#define PG8_WAIT_L(n) asm volatile("s_waitcnt lgkmcnt(" #n ")" ::: "memory")
#define PG8_BAR __builtin_amdgcn_s_barrier()
#define PG8_SCHED __builtin_amdgcn_sched_barrier(0)
    Unit cur, nxt; nxt.pm = 0; nxt.pn = 0; nxt.arow = 0; nxt.ord = 0; int ui = 0;
    if (!S.next(0, cur)) return;
    cur.ord = 0;
    f32x4 acc[2][2][4][2];
#pragma unroll
    for (int a = 0; a < 2; ++a)
#pragma unroll
        for (int b = 0; b < 2; ++b)
#pragma unroll
            for (int m = 0; m < 4; ++m)
#pragma unroll
                for (int n = 0; n < 2; ++n) acc[a][b][m][n] = (f32x4){0.f, 0.f, 0.f, 0.f};
    bf16x8 At[4][2], B0[2][2], B1[2][2];
    const char* cA = (const char*)g.A + (ptrdiff_t)cur.arow * (ptrdiff_t)(K * 2); const char* cB = (const char*)g.Bt + (size_t)cur.pn * tstep;
    PG8_STAGE(PG8_SB(0, 0), cB, voffB); PG8_STAGE(PG8_SA(0, 0), cA, voffA); PG8_STAGE(PG8_SB(0, 1), cB + hstep, voffB); PG8_STAGE(PG8_SA(0, 1), cA + hstep, voffA);
    if (wr == 1) PG8_BAR;
    PG8_WAIT_V(0); PG8_BAR;
    PG8_STAGE(PG8_SB(1, 0), cB + kstep, voffB); PG8_STAGE(PG8_SA(1, 0), cA + kstep, voffA); PG8_STAGE(PG8_SB(1, 1), cB + hstep + kstep, voffB);
    PG8_BAR;
    for (;;) {
        const bool has_next = S.next(ui + 1, nxt); nxt.ord = ui + 1;
        const char* nA = has_next ? (const char*)g.A + (ptrdiff_t)nxt.arow * (ptrdiff_t)(K * 2) : cA; const char* nB = has_next ? (const char*)g.Bt + (size_t)nxt.pn * tstep : cB;
        for (int t = 0; t < nt; t += 2) {
            const bool last = (t == nt - 2);
            const char* a1 = cA + (size_t)(t + 1) * kstep;
            const char* a2 = last ? nA : cA + (size_t)(t + 2) * kstep; const char* b2 = last ? nB : cB + (size_t)(t + 2) * kstep;
            const char* a3 = a2 + kstep; const char* b3 = b2 + kstep;
            PG8_LDB(B0, 0, 0); PG8_LDB(B1, 0, 1); PG8_LDA(At, 0, 0); PG8_STAGE(PG8_SA(1, 1), a1 + hstep, voffA);
            PG8_WAIT_V(8); PG8_WAIT_L(0); PG8_BAR; PG8_MMA(0, 0, At, B0); PG8_MMA(0, 1, At, B1); PG8_BAR; PG8_SCHED;
            PG8_LDA(At, 0, 1); PG8_STAGE(PG8_SB(0, 0), b2, voffB); PG8_STAGE(PG8_SA(0, 0), a2, voffA); PG8_STAGE(PG8_SB(0, 1), b2 + hstep, voffB);
            PG8_WAIT_V(8); PG8_WAIT_L(0); PG8_BAR; PG8_MMA(1, 0, At, B0); PG8_MMA(1, 1, At, B1); PG8_BAR; PG8_SCHED;
            PG8_LDB(B0, 1, 0); PG8_LDB(B1, 1, 1); PG8_LDA(At, 1, 0); PG8_STAGE(PG8_SA(0, 1), a2 + hstep, voffA);
            PG8_WAIT_V(8); PG8_WAIT_L(0); PG8_BAR; PG8_MMA(0, 0, At, B0); PG8_MMA(0, 1, At, B1); PG8_BAR; PG8_SCHED;
            PG8_LDA(At, 1, 1); PG8_STAGE(PG8_SB(1, 0), b3, voffB); PG8_STAGE(PG8_SA(1, 0), a3, voffA); PG8_STAGE(PG8_SB(1, 1), b3 + hstep, voffB);
            PG8_WAIT_V(8); PG8_WAIT_L(0); PG8_BAR; PG8_MMA(1, 0, At, B0); PG8_MMA(1, 1, At, B1); PG8_BAR; PG8_SCHED;
        }
        E(acc, cur, wr, wc, fr, fq);
        if (!has_next) break;
#pragma unroll
        for (int a = 0; a < 2; ++a)
#pragma unroll
            for (int b = 0; b < 2; ++b)
#pragma unroll
                for (int m = 0; m < 4; ++m)
#pragma unroll
                    for (int n = 0; n < 2; ++n) acc[a][b][m][n] = (f32x4){0.f, 0.f, 0.f, 0.f};
        cur = nxt; cA = nA; cB = nB; ++ui;
    }
    PG8_WAIT_V(0);
    if (wr == 0) PG8_BAR;
    PG8_BAR;
#undef PG8_SA
#undef PG8_SB
#undef PG8_STAGE
#undef PG8_LDA
#undef PG8_LDB
#undef PG8_MMA
#undef PG8_WAIT_V
#undef PG8_WAIT_L
#undef PG8_BAR
#undef PG8_SCHED
}
}

DI float ssq_rs(const float* ssq, size_t row) {
    const f32x4* q = (const f32x4*)(ssq + row * 16);
    const f32x4 a = q[0], b = q[1], c = q[2], d = q[3];
    const float s = (((a[0] + a[1]) + (a[2] + a[3])) + ((b[0] + b[1]) + (b[2] + b[3]))) + (((c[0] + c[1]) + (c[2] + c[3])) + ((d[0] + d[1]) + (d[2] + d[3])));
    return rsqrtf(s * (1.0f / 1024.0f) + 1e-6f);
}

constexpr int RST_OFF = 131072 + 4096, RST_MAXU = 23;
DI void build_rstab(LAS unsigned char* lds, const pg8::StaticOrder& S, const float* ssq, int row_max) {
    LAS float* RST = (LAS float*)(lds + RST_OFF);
    const int tid = tid_(), r = tid & 255, par = tid >> 8;
    for (int i = par; i < RST_MAXU; i += 2) { pg8::Unit u; if (!S.next(i, u)) break;
        int grow = u.arow + r; grow = grow < 0 ? 0 : (grow > row_max ? row_max : grow);
        RST[i * 256 + r] = ssq_rs(ssq, (size_t)grow); }
    __syncthreads();
}
struct EpiScale {
    static constexpr bool PERM = true;
    bf16_t* O; int ldc; const LAS float* RST;
    DI void operator()(const f32x4 (&acc)[2][2][4][2], const pg8::Unit& u, int wr, int wc, int fr, int fq) const {
        const int row0 = u.pm * 256 + wr * 64 + fr, col0 = u.pn * 256 + wc * 32 + 8 * fq;
        const int tsel = u.pn >> 1; const int actsel = (tsel == 0) ? 1 : ((tsel == 2 || tsel == 5) ? 2 : 0);
#pragma unroll
        for (int ai = 0; ai < 2; ++ai)
#pragma unroll
            for (int m = 0; m < 4; ++m) {
                const size_t row = (size_t)(row0 + ai * 128 + m * 16); const float rs = RST[u.ord * 256 + wr * 64 + fr + ai * 128 + m * 16];
                bf16_t* rowp = O + row * ldc + col0;
#pragma unroll
                for (int bj = 0; bj < 2; ++bj) { f32x4 v0 = acc[ai][bj][m][0] * rs, v1 = acc[ai][bj][m][1] * rs;
                    if (actsel == 1) {
#pragma unroll
                        for (int j = 0; j < 4; ++j) { v0[j] = geluf_(v0[j]); v1[j] = geluf_(v1[j]); } }
                    else if (actsel == 2) {
#pragma unroll
                        for (int j = 0; j < 4; ++j) { v0[j] = siluf_(v0[j]); v1[j] = siluf_(v1[j]); } }
                    u32x4 w; w.x = cvt_pk_bf16(v0[0], v0[1]); w.y = cvt_pk_bf16(v0[2], v0[3]); w.z = cvt_pk_bf16(v1[0], v1[1]); w.w = cvt_pk_bf16(v1[2], v1[3]);
                    *(u32x4*)(rowp + bj * 128) = w; }
            }
    }
};
struct EpiGelu {
    static constexpr bool PERM = true;
    bf16_t* O; int ldc; const LAS float* RST; const float* bias; float* vst;
    DI void operator()(const f32x4 (&acc)[2][2][4][2], const pg8::Unit& u, int wr, int wc, int fr, int fq) const {
        const int row0 = u.pm * 256 + wr * 64 + fr, col0 = u.pn * 256 + wc * 32 + 8 * fq;
        f32x4 bv[2][2];
#pragma unroll
        for (int bj = 0; bj < 2; ++bj)
#pragma unroll
            for (int n = 0; n < 2; ++n) bv[bj][n] = *(const f32x4*)(bias + col0 + bj * 128 + 4 * n);
#pragma unroll
        for (int ai = 0; ai < 2; ++ai)
#pragma unroll
            for (int m = 0; m < 4; ++m) {
                const size_t row = (size_t)(row0 + ai * 128 + m * 16); const float rs = RST[u.ord * 256 + wr * 64 + fr + ai * 128 + m * 16];
                bf16_t* rowp = O + row * ldc + col0; float s1 = 0.f, s2 = 0.f;
#pragma unroll
                for (int bj = 0; bj < 2; ++bj) { f32x4 v0 = acc[ai][bj][m][0] * rs + bv[bj][0], v1 = acc[ai][bj][m][1] * rs + bv[bj][1];
#pragma unroll
                    for (int j = 0; j < 4; ++j) { v0[j] = geluf_(v0[j]); v1[j] = geluf_(v1[j]); s1 += v0[j] + v1[j]; s2 += v0[j] * v0[j] + v1[j] * v1[j]; }
                    u32x4 w; w.x = cvt_pk_bf16(v0[0], v0[1]); w.y = cvt_pk_bf16(v0[2], v0[3]); w.z = cvt_pk_bf16(v1[0], v1[1]); w.w = cvt_pk_bf16(v1[2], v1[3]);
                    *(u32x4*)(rowp + bj * 128) = w; }
                if (u.pn >= 4) {
                    s1 += __shfl_xor(s1, 16); s1 += __shfl_xor(s1, 32); s2 += __shfl_xor(s2, 16); s2 += __shfl_xor(s2, 32);
                    if (fq == 0) *(f32x2*)(vst + (row * 16 + (size_t)((u.pn - 4) * 4 + wc)) * 2) = (f32x2){s1, s2};
                }
            }
    }
};
struct EpiRes {
    static constexpr bool PERM = false;
    bf16_t* hb; float* ssq;
    DI void operator()(const f32x4 (&acc)[2][2][4][2], const pg8::Unit& u, int wr, int wc, int fr, int fq) const {
        const int row0 = u.pm * 256 + wr * 64 + fr, col0 = u.pn * 256 + wc * 32 + 4 * fq;
#pragma unroll
        for (int ai = 0; ai < 2; ++ai) {
            u32x2 rr[4][2][2];
#pragma unroll
            for (int m = 0; m < 4; ++m) { const size_t off = (size_t)(row0 + ai * 128 + m * 16) * DM + col0;
#pragma unroll
                for (int bj = 0; bj < 2; ++bj)
#pragma unroll
                    for (int n = 0; n < 2; ++n) rr[m][bj][n] = *(const u32x2*)(hb + off + bj * 128 + n * 16); }
#pragma unroll
            for (int m = 0; m < 4; ++m) { const size_t row = (size_t)(row0 + ai * 128 + m * 16); const size_t off = row * DM + col0; float sq = 0.f;
#pragma unroll
                for (int bj = 0; bj < 2; ++bj)
#pragma unroll
                    for (int n = 0; n < 2; ++n) {
                        const u32x2 r = rr[m][bj][n]; const f32x4 v = acc[ai][bj][m][n] + (f32x4){bflo(r.x), bfhi(r.x), bflo(r.y), bfhi(r.y)};
                        u32x2 w; w.x = cvt_pk_bf16(v[0], v[1]); w.y = cvt_pk_bf16(v[2], v[3]); *(u32x2*)(hb + off + bj * 128 + n * 16) = w;
                        sq += (v[0] * v[0] + v[1] * v[1]) + (v[2] * v[2] + v[3] * v[3]);
                    }
                sq += __shfl_xor(sq, 16); sq += __shfl_xor(sq, 32);
                if (fq == 0) ssq[row * 16 + (size_t)(u.pn * 4 + wc)] = sq; }
        }
    }
};

template <int CTRL> DI float dppmov(float oldv, float src) { return __builtin_bit_cast(float, __builtin_amdgcn_update_dpp(__builtin_bit_cast(int, oldv), __builtin_bit_cast(int, src), CTRL, 0xf, 0xf, false)); }
struct EpiFfn {
    static constexpr bool PERM = true;
    bf16_t* act; const LAS float* RST; const float* cw; const float* cb; LAS float* X;
    DI void operator()(f32x4 (&acc)[2][2][4][2], const pg8::Unit& u, int wr, int wc, int fr_, int fq_) const {
        int fr = fr_, fq = fq_; asm volatile("" : "+v"(fr), "+v"(fq));
        const int bb = u.pm / 33, ii = u.pm - bb * 33; const int tok0 = ii * 254 - 2;
        const int chl = wc * 32 + 8 * fq, ch = u.pn * 128 + chl;
#pragma unroll
        for (int ai = 0; ai < 2; ++ai)
#pragma unroll
            for (int m = 0; m < 4; ++m) {
                const int r = 128 * ai + 64 * wr + 16 * m + fr, tok = tok0 + r;
                const float rs = RST[u.ord * 256 + r];
#pragma unroll
                for (int n = 0; n < 2; ++n) { acc[ai][0][m][n] = (tok >= 0) ? acc[ai][0][m][n] * rs : (f32x4){0.f, 0.f, 0.f, 0.f}; acc[ai][1][m][n] = acc[ai][1][m][n] * rs; }
            }
#pragma unroll
        for (int ai = 0; ai < 2; ++ai) { const int slot = ai * 2 + wr;
            if (fr >= 14) {
#pragma unroll
                for (int n = 0; n < 2; ++n) *(LAS f32x4*)(X + ((slot * 2 + (fr - 14)) * 128 + chl + 4 * n)) = acc[ai][0][3][n]; } }
        asm volatile("s_waitcnt lgkmcnt(0)" ::: "memory"); __builtin_amdgcn_s_barrier(); asm volatile("" ::: "memory"); __builtin_amdgcn_s_barrier(); asm volatile("" ::: "memory");
        f32x4 w0[2], w1[2], w2[2], bv[2];
#pragma unroll
        for (int n = 0; n < 2; ++n) { w0[n] = *(const f32x4*)(cw + ch + 4 * n); w1[n] = *(const f32x4*)(cw + DFF + ch + 4 * n); w2[n] = *(const f32x4*)(cw + 2 * DFF + ch + 4 * n); bv[n] = *(const f32x4*)(cb + ch + 4 * n); }
#pragma unroll
        for (int ai = 0; ai < 2; ++ai) {
            const int slot = ai * 2 + wr; f32x4 prev[2];
            { const int rowsel = (fr == 15) ? 1 : 0; const int sl = slot > 0 ? slot - 1 : 0;
#pragma unroll
              for (int n = 0; n < 2; ++n) { prev[n] = *(const LAS f32x4*)(X + ((sl * 2 + rowsel) * 128 + chl + 4 * n)); if (slot == 0) prev[n] = (f32x4){0.f, 0.f, 0.f, 0.f}; } }
#pragma unroll
            for (int m = 0; m < 4; ++m) {
                const int r = 128 * ai + 64 * wr + 16 * m + fr, tok = tok0 + r; float o[8];
#pragma unroll
                for (int n = 0; n < 2; ++n)
#pragma unroll
                    for (int j = 0; j < 4; ++j) { const float g0 = acc[ai][0][m][n][j], p = prev[n][j];
                        const float rot1 = dppmov<0x121>(p, p), rot2 = dppmov<0x122>(p, p);
                        const float g1 = dppmov<0x111>(rot1, g0), g2 = dppmov<0x112>(rot2, g0);
                        const float cv = bv[n][j] + w0[n][j] * g2 + w1[n][j] * g1 + w2[n][j] * g0;
                        o[n * 4 + j] = siluf_(cv) * acc[ai][1][m][n][j]; }
                u32x4 ow; ow.x = cvt_pk_bf16(o[0], o[1]); ow.y = cvt_pk_bf16(o[2], o[3]); ow.z = cvt_pk_bf16(o[4], o[5]); ow.w = cvt_pk_bf16(o[6], o[7]);
                if (r >= 2 && tok < TSEQ) *(u32x4*)(act + (size_t)(bb * 8192 + tok) * DFF + ch) = ow;
                prev[0] = acc[ai][0][m][0]; prev[1] = acc[ai][0][m][1];
            }
        }
    }
};

template <class Epi> DI void run_gemm_ffn(LAS unsigned char* lds, int vc, const bf16_t* A, const bf16_t* Bt, const float* ssq, const Epi& E) {
    pg8::Gemm g{A, Bt, MTOK, 5632, 1024}; pg8::StaticOrder S; S.init_ffn((int)gridDim.x, vc);
    build_rstab(lds, S, ssq, MTOK - 1);
    pg8::gemm_phase4<Epi>(lds, g, S, E);
}
template <class Epi, bool P4 = true> DI void run_gemm(LAS unsigned char* lds, int vc, const bf16_t* A, const bf16_t* Bt, int Mrows, int N, int K, const Epi& E, const float* ssq = nullptr) {
    pg8::Gemm g{A, Bt, Mrows, N, K}; pg8::StaticOrder S; S.init(Mrows, N, (int)gridDim.x, vc);
    if (ssq) build_rstab(lds, S, ssq, Mrows - 1);
    if (P4) pg8::gemm_phase4<Epi>(lds, g, S, E); else pg8::gemm_phase<Epi>(lds, g, S, E);
}

DI void transpose_item(const float* W, int K, int N, bf16_t* WT, const float* gain, LAS float* scr, int item, int lane, bool ffn_remap = false) {
    const int nblk = N / 32, kb = item / nblk, nb = item % nblk, k0 = 64 * kb, n0 = 32 * nb;
    const int r0 = ffn_remap ? ((n0 < DFF) ? (n0 / 128) * 256 + (n0 % 128) : ((n0 - DFF) / 128) * 256 + 128 + ((n0 - DFF) % 128)) : n0;
#pragma unroll 8
    for (int i = 0; i < 32; ++i) { const int kk = 2 * i + (lane >> 5); float v = W[(size_t)(k0 + kk) * N + n0 + (lane & 31)]; if (gain) v *= gain[k0 + kk]; scr[kk * 33 + (lane & 31)] = v; }
    asm volatile("s_waitcnt lgkmcnt(0)" ::: "memory");
    const int c = lane & 7;
#pragma unroll
    for (int j = 0; j < 4; ++j) { const int n = (lane >> 3) + 8 * j; const LAS float* s = scr + (8 * c) * 33 + n;
        u32x4 o; o.x = cvt_pk_bf16(s[0 * 33], s[1 * 33]); o.y = cvt_pk_bf16(s[2 * 33], s[3 * 33]); o.z = cvt_pk_bf16(s[4 * 33], s[5 * 33]); o.w = cvt_pk_bf16(s[6 * 33], s[7 * 33]);
        *(u32x4*)(WT + (size_t)(r0 + n) * K + k0 + 8 * c) = o; }
    asm volatile("s_waitcnt lgkmcnt(0)" ::: "memory");
}
DI void phase_prep(LAS unsigned char* lds, const Args& a) {
    const int tid = tid_(), lane = tid & 63, wave = tid >> 6;
    const int gw = bid_() * 8 + wave, NGW = (int)gridDim.x * 8;
    unsigned char* ws = a.ws;
    LAS float* scr = (LAS float*)(lds + wave * 8448);
    constexpr int I_IN0 = 16 * 96, I_OUT = 16 * 32, I_UP = 16 * 176, I_DN = 44 * 32, I_IN1 = 16 * 64;
    constexpr int NITEMS = I_IN0 + I_OUT + I_UP + I_DN + I_IN1 + I_OUT + I_UP + I_DN;
    for (int it = gw; it < NITEMS; it += NGW) {
        int r = it;
        if (r < I_IN0) { transpose_item(a.in[4], 1024, 3072, (bf16_t*)(ws + WS_WIN0), a.in[1], scr, r, lane); continue; } r -= I_IN0;
        if (r < I_OUT) { transpose_item(a.in[14], 1024, 1024, (bf16_t*)(ws + WS_WOUT0), nullptr, scr, r, lane); continue; } r -= I_OUT;
        if (r < I_UP) { transpose_item(a.in[22], 1024, 5632, (bf16_t*)(ws + WS_WUP0), a.in[2], scr, r, lane, true); continue; } r -= I_UP;
        if (r < I_DN) { transpose_item(a.in[25], 2816, 1024, (bf16_t*)(ws + WS_WDN0), nullptr, scr, r, lane); continue; } r -= I_DN;
        if (r < I_IN1) { transpose_item(a.in[15], 1024, 2048, (bf16_t*)(ws + WS_WIN1), a.in[1] + 1024, scr, r, lane); continue; } r -= I_IN1;
        if (r < I_OUT) { transpose_item(a.in[21], 1024, 1024, (bf16_t*)(ws + WS_WOUT1), nullptr, scr, r, lane); continue; } r -= I_OUT;
        if (r < I_UP) { transpose_item(a.in[22] + (size_t)1024 * 5632, 1024, 5632, (bf16_t*)(ws + WS_WUP1), a.in[2] + 1024, scr, r, lane, true); continue; } r -= I_UP;
        transpose_item(a.in[25] + (size_t)2816 * 1024, 2816, 1024, (bf16_t*)(ws + WS_WDN1), nullptr, scr, r, lane);
    }
    { const float* w_s = a.in[19]; bf16_t* wsc = (bf16_t*)(ws + WS_WSC);
      for (int i = bid_() * NTHR + tid; i < 8 * 128 * 128; i += (int)gridDim.x * NTHR) { const int t = (i >> 7) & 127, s = i & 127; wsc[i] = (s <= t) ? f2bf(w_s[i]) : (bf16_t)0; } }
    { const float* x = a.in[0]; bf16_t* xb = (bf16_t*)(ws + WS_HB); float* ssq = (float*)(ws + WS_SSQ);
      for (int m = gw; m < MTOK; m += NGW) {
          const f32x4* xr = (const f32x4*)(x + (size_t)m * DM) + lane; f32x4 v[4]; float s = 0.f;
#pragma unroll
          for (int j = 0; j < 4; ++j) { v[j] = xr[64 * j]; s += (v[j][0] * v[j][0] + v[j][1] * v[j][1]) + (v[j][2] * v[j][2] + v[j][3] * v[j][3]); }
          s = wave_sum(s);
          u32x2* o8 = (u32x2*)(xb + (size_t)m * DM) + lane;
#pragma unroll
          for (int j = 0; j < 4; ++j) { u32x2 w; w.x = cvt_pk_bf16(v[j][0], v[j][1]); w.y = cvt_pk_bf16(v[j][2], v[j][3]); o8[64 * j] = w; }
          if (lane < 16) ssq[(size_t)m * 16 + lane] = (lane == 0) ? s : 0.f;
      } }
}

template <bool FINAL>
DI void lru_item(LAS unsigned char* lds, const Args& a, int it) {
    const int tid = tid_(), lane = tid & 63, w = tid >> 6;
    const int b = it >> 5, cb = (it >> 2) & 7, seg = it & 3;
    const bf16_t* z = (const bf16_t*)(a.ws + WS_Z); bf16_t* mix = (bf16_t*)(a.ws + WS_MIX); float* agg = (float*)(a.ws + WS_LRUAGG);
    LAS bf16_t* WaT = (LAS bf16_t*)lds;
    LAS bf16_t* WxT = WaT + 64 * 72;
    LAS bf16_t* XR = WxT + 64 * 72;
    LAS bf16_t* XC = XR + 132 * 64;
    LAS float* AA = (LAS float*)(XC + 128 * 72);
    LAS float* UU = AA + 128 * 64;
    LAS float* SPp = UU + 128 * 64;
    LAS float* SHh = SPp + 512;
    LAS float* TAB = SHh + 512;
    LAS bf16_t* YT = (LAS bf16_t*)(TAB + 512);
    static_assert((64 * 72 * 2 + 132 * 64 + 128 * 72) * 2 + (128 * 64 * 2 + 512 * 3) * 4 + 128 * 64 * 2 <= 158720, "lru lds");
    { const float* wa = a.in[7] + cb * 4096; const float* wx = a.in[9] + cb * 4096;
#pragma unroll
      for (int r = 0; r < 8; ++r) { const int e = tid + 512 * r, i = e >> 6, j = e & 63; WaT[j * 72 + i] = f2bf(wa[e]); WxT[j * 72 + i] = f2bf(wx[e]); }
      if (tid < 64) { const int ch = cb * 64 + tid;
#pragma unroll
          for (int k = 0; k < 4; ++k) TAB[k * 64 + tid] = a.in[5][k * 512 + ch];
          TAB[256 + tid] = a.in[6][ch]; TAB[320 + tid] = a.in[8][ch]; TAB[384 + tid] = a.in[10][ch]; TAB[448 + tid] = log1pf(expf(-a.in[11][ch])); } }
    const int c = tid & 63, sub = tid >> 6;
    float h = 0.f, Ptot = 1.f;
    if (FINAL) for (int j = 0; j < seg; ++j) { const f32x2 pq = *(const f32x2*)(agg + ((size_t)((b * 4 + j) * 512 + cb * 64 + c)) * 2); h = pq[0] * h + pq[1]; }
    const bf16_t* zb = z + (size_t)b * TSEQ * 3072 + cb * 64 + (tid & 7) * 8;
    const int prow = tid >> 3;
    u32x4 pfx[3], pfy[2];
    { const int t0 = seg * 2048;
#pragma unroll
      for (int k = 0; k < 3; ++k) { const int r = prow + 64 * k, tok = t0 - 3 + r; u32x4 v = (u32x4){0u, 0u, 0u, 0u};
          if (r < 131 && tok >= 0) v = *(const u32x4*)(zb + (size_t)tok * 3072 + 512);
          if (r < 131) *(LAS u32x4*)(XR + r * 64 + (tid & 7) * 8) = v; }
      if (FINAL) {
#pragma unroll
          for (int k = 0; k < 2; ++k) pfy[k] = *(const u32x4*)(zb + (size_t)(t0 + prow + 64 * k) * 3072); } }
    __syncthreads();
    const float cw0 = TAB[c], cw1 = TAB[64 + c], cw2 = TAB[128 + c], cw3 = TAB[192 + c], cbv = TAB[256 + c];
    for (int tile = 0; tile < 16; ++tile) {
        const int t0 = seg * 2048 + tile * 128; const bool more = tile + 1 < 16;
        if (more) {
#pragma unroll
            for (int k = 0; k < 3; ++k) { const int r = prow + 64 * k; if (r < 131) pfx[k] = *(const u32x4*)(zb + (size_t)(t0 + 128 - 3 + r) * 3072 + 512); }
        }
#pragma unroll
        for (int i = 0; i < 16; ++i) { const int t = sub + 8 * i;
            const float xc = cbv + cw0 * bf2f(XR[t * 64 + c]) + cw1 * bf2f(XR[(t + 1) * 64 + c]) + cw2 * bf2f(XR[(t + 2) * 64 + c]) + cw3 * bf2f(XR[(t + 3) * 64 + c]);
            XC[t * 72 + c] = f2bf(xc); }
        __syncthreads();
        if (FINAL) {
#pragma unroll
            for (int k = 0; k < 2; ++k) *(LAS u32x4*)(YT + (prow + 64 * k) * 64 + (tid & 7) * 8) = pfy[k];
            if (more) {
#pragma unroll
                for (int k = 0; k < 2; ++k) pfy[k] = *(const u32x4*)(zb + (size_t)(t0 + 128 + prow + 64 * k) * 3072); }
        }
        {
            f32x4 accA[4], accX[4];
#pragma unroll
            for (int nt = 0; nt < 4; ++nt) { accA[nt] = (f32x4){0.f, 0.f, 0.f, 0.f}; accX[nt] = (f32x4){0.f, 0.f, 0.f, 0.f}; }
#pragma unroll
            for (int k = 0; k < 2; ++k) { const bf16x8 av = *(const LAS bf16x8*)(XC + (w * 16 + (lane & 15)) * 72 + k * 32 + 8 * (lane >> 4));
#pragma unroll
                for (int nt = 0; nt < 4; ++nt) { const bf16x8 ba = *(const LAS bf16x8*)(WaT + (nt * 16 + (lane & 15)) * 72 + k * 32 + 8 * (lane >> 4)), bx = *(const LAS bf16x8*)(WxT + (nt * 16 + (lane & 15)) * 72 + k * 32 + 8 * (lane >> 4));
                    accA[nt] = __builtin_amdgcn_mfma_f32_16x16x32_bf16(av, ba, accA[nt], 0, 0, 0); accX[nt] = __builtin_amdgcn_mfma_f32_16x16x32_bf16(av, bx, accX[nt], 0, 0, 0); } }
#pragma unroll
            for (int nt = 0; nt < 4; ++nt) { const int cc = nt * 16 + (lane & 15);
                const float ba = TAB[320 + cc], bx = TAB[384 + cc], spl = TAB[448 + cc];
#pragma unroll
                for (int j = 0; j < 4; ++j) { const int t = w * 16 + 4 * (lane >> 4) + j;
                    const float r = sigmoidf_(accA[nt][j] + ba), ig = sigmoidf_(accX[nt][j] + bx);
                    const float av = __expf(-8.0f * r * spl);
                    const float xc = bf2f(XC[t * 72 + cc]);
                    AA[t * 64 + cc] = av; UU[t * 64 + cc] = __builtin_amdgcn_sqrtf(fmaxf(1.0f - av * av, 0.f)) * (ig * xc); }
            }
        }
        __syncthreads();
        if (more) {
#pragma unroll
            for (int k = 0; k < 3; ++k) { const int r = prow + 64 * k; if (r < 131) *(LAS u32x4*)(XR + r * 64 + (tid & 7) * 8) = pfx[k]; }
        }
        { float P = 1.f, Hh = 0.f;
#pragma unroll
          for (int i = 0; i < 16; ++i) { const int t = sub * 16 + i; const float a_ = AA[t * 64 + c], u_ = UU[t * 64 + c]; Hh = a_ * Hh + u_; P *= a_; }
          SPp[sub * 64 + c] = P; SHh[sub * 64 + c] = Hh; }
        __syncthreads();
        float hin = h;
#pragma unroll
        for (int s = 0; s < 8; ++s) { const float p = SPp[s * 64 + c], q = SHh[s * 64 + c]; if (s < sub) hin = p * hin + q; h = p * h + q; Ptot *= p; }
        if (FINAL) {
            float hh = hin;
#pragma unroll
            for (int i = 0; i < 16; ++i) { const int t = sub * 16 + i;
                hh = AA[t * 64 + c] * hh + UU[t * 64 + c];
                const float y = bf2f(YT[t * 64 + c]);
                YT[t * 64 + c] = f2bf(y * hh); }
            __syncthreads();
#pragma unroll
            for (int k = 0; k < 2; ++k) { const int r = prow + 64 * k;
                *(u32x4*)(mix + ((size_t)b * TSEQ + t0 + r) * 1024 + cb * 64 + (tid & 7) * 8) = *(const LAS u32x4*)(YT + r * 64 + (tid & 7) * 8); }
        }
    }
    if (!FINAL && sub == 0) *(f32x2*)(agg + ((size_t)((b * 4 + seg) * 512 + cb * 64 + c)) * 2) = (f32x2){Ptot, h};
    __syncthreads();
}

template <bool FINAL>
DI void hgrn_item(LAS unsigned char* lds, const Args& a, int it) {
    const int tid = tid_(), lane = tid & 63, w = tid >> 6, l15 = lane & 15, q4 = lane >> 4;
    const int bh = it >> 3, seg = it & 7, b = bh >> 2, hd = bh & 3;
    const bf16_t* z = (const bf16_t*)(a.ws + WS_Z); bf16_t* mix = (bf16_t*)(a.ws + WS_MIX);
    float* HGS = (float*)(a.ws + WS_HGS); float* HGD = (float*)(a.ws + WS_HGD);
    LAS bf16_t* QS = (LAS bf16_t*)lds;
    LAS bf16_t* KS = QS + 64 * 136;
    LAS bf16_t* KSt = KS + 64 * 136;
    LAS bf16_t* Vt = KSt + 128 * 72;
    LAS bf16_t* Pm = Vt + 128 * 72;
    LAS bf16_t* St = Pm + 64 * 72;
    LAS float* CS = (LAS float*)(St + 128 * 136);
    LAS float* EM = CS + 512; LAS float* EL = EM + 128; LAS float* DEC = EL + 128; LAS float* GN = DEC + 128;
    LAS bf16_t* RV = (LAS bf16_t*)(GN + 128);
    LAS bf16_t* RF = Pm;
    LAS bf16_t* RQ = RF + 64 * 128;
    LAS float* OB = (LAS float*)lds;
    static_assert((64 * 136 * 2 + 128 * 72 * 2 + 64 * 72 + 128 * 136) * 2 + (512 + 128 * 4) * 4 + 64 * 128 * 2 <= 158720, "hgrn lds");
    static_assert(64 * 132 * 4 <= 64 * 136 * 2 * 2 && 2 * 64 * 128 <= 64 * 72 + 128 * 136, "hgrn aliases");
    const int dk = tid & 127, sub = tid >> 7;
    float lbv;
    { const float* lg = a.in[12]; const int col = hd * 128 + dk; const float l0 = lg[col], l1 = lg[512 + col], l2 = lg[1024 + col];
      const float mx = fmaxf(l0, fmaxf(l1, l2)); const float e0 = __expf(l0 - mx), e1 = __expf(l1 - mx), e2 = __expf(l2 - mx); lbv = e0 / (e0 + e1 + e2); }
    if (tid < 128) GN[tid] = a.in[13][tid];
    f32x4 Sacc[8];
#pragma unroll
    for (int nt = 0; nt < 8; ++nt) Sacc[nt] = (f32x4){0.f, 0.f, 0.f, 0.f};
    if (FINAL) for (int j = 0; j < seg; ++j) { const int itj = bh * 8 + j;
#pragma unroll
        for (int nt = 0; nt < 8; ++nt) { const float d = HGD[(size_t)itj * 128 + nt * 16 + l15];
            const f32x4 sj = *(const f32x4*)(HGS + (size_t)itj * 16384 + (size_t)((w * 8 + nt) * 64 + lane) * 4); Sacc[nt] = Sacc[nt] * d + sj; } }
    float dtot = 1.f;
    const size_t tok0 = (size_t)b * TSEQ + seg * 1024;
    const bf16_t* zbase = z + (tok0 + (tid >> 4)) * 3072 + hd * 128 + (tid & 15) * 8;
    const int roff = (tid >> 4) * 128 + (tid & 15) * 8;
    u32x4 pf_f[2], pf_v[2], pf_q[2];
#pragma unroll
    for (int k = 0; k < 2; ++k) { const bf16_t* p = zbase + (size_t)(32 * k) * 3072; pf_f[k] = *(const u32x4*)(p + 1536); pf_v[k] = *(const u32x4*)(p + 2048); if (FINAL) pf_q[k] = *(const u32x4*)(p + 1024); }
#pragma unroll
    for (int k = 0; k < 2; ++k) { *(LAS u32x4*)(RF + roff + k * 4096) = pf_f[k]; *(LAS u32x4*)(RV + roff + k * 4096) = pf_v[k]; if (FINAL) *(LAS u32x4*)(RQ + roff + k * 4096) = pf_q[k]; }
    __syncthreads();
    for (int ck = 0; ck < 16; ++ck) {
        const size_t rowbase = tok0 + ck * 64;
        const bool more = ck + 1 < 16;
        if (more && !FINAL) {
#pragma unroll
            for (int k = 0; k < 2; ++k) { const bf16_t* p = zbase + (size_t)((ck + 1) * 64 + 32 * k) * 3072; pf_f[k] = *(const u32x4*)(p + 1536); pf_v[k] = *(const u32x4*)(p + 2048); }
        }
        float pf[16], kf[16];
        { float run = 1.f;
#pragma unroll
          for (int i = 0; i < 16; ++i) { const float fl = bf2f(RF[(sub * 16 + i) * 128 + dk]);
              const float f = lbv + (1.0f - lbv) * sigmoidf_(fl); kf[i] = 1.0f - f; run *= f; pf[i] = run; }
          CS[sub * 128 + dk] = run; }
        __syncthreads();
        {
            const float c0 = CS[dk], c1 = CS[128 + dk], c2 = CS[256 + dk], c3 = CS[384 + dk];
            const float offs = (sub > 0 ? c0 : 1.f) * (sub > 1 ? c1 : 1.f) * (sub > 2 ? c2 : 1.f);
            const float pmid = c0 * c1, plast = pmid * c2 * c3; const float rpmid = __builtin_amdgcn_rcpf(pmid);
#pragma unroll
            for (int hq = 0; hq < 2; ++hq) { unsigned kw[4], vw[4];
#pragma unroll
                for (int i3 = 0; i3 < 4; ++i3) { const int i2 = hq * 4 + i3; const int s = sub * 16 + 2 * i2; const float P0 = offs * pf[2 * i2], P1 = offs * pf[2 * i2 + 1];
                    kw[i3] = cvt_pk_bf16(kf[2 * i2] * pmid * __builtin_amdgcn_rcpf(P0), kf[2 * i2 + 1] * pmid * __builtin_amdgcn_rcpf(P1));
                    vw[i3] = (unsigned)RV[s * 128 + dk] | ((unsigned)RV[(s + 1) * 128 + dk] << 16);
                    if (FINAL) { KS[s * 136 + dk] = (bf16_t)(kw[i3] & 0xffffu); KS[(s + 1) * 136 + dk] = (bf16_t)(kw[i3] >> 16);
                        const float q0 = bf2f(RQ[s * 128 + dk]), q1 = bf2f(RQ[(s + 1) * 128 + dk]);
                        QS[s * 136 + dk] = f2bf(q0 * (P0 * rpmid)); QS[(s + 1) * 136 + dk] = f2bf(q1 * (P1 * rpmid)); } }
                *(LAS u32x4*)(KSt + dk * 72 + sub * 16 + hq * 8) = (u32x4){kw[0], kw[1], kw[2], kw[3]};
                *(LAS u32x4*)(Vt + dk * 72 + sub * 16 + hq * 8) = (u32x4){vw[0], vw[1], vw[2], vw[3]}; }
            if (sub == 0) { EM[dk] = pmid; EL[dk] = c2 * c3; DEC[dk] = plast; }
            dtot *= plast;
        }
        __syncthreads();
        if (more && FINAL) {
#pragma unroll
            for (int k = 0; k < 2; ++k) { const bf16_t* p = zbase + (size_t)((ck + 1) * 64 + 32 * k) * 3072; pf_f[k] = *(const u32x4*)(p + 1536); pf_v[k] = *(const u32x4*)(p + 2048); pf_q[k] = *(const u32x4*)(p + 1024); }
        }
        f32x4 oacc[4];
        u32x4 gpre[2];
        if (FINAL) {
#pragma unroll
            for (int nt = 0; nt < 8; ++nt) { const float em = EM[nt * 16 + l15];
#pragma unroll
                for (int j = 0; j < 4; ++j) St[(16 * w + 4 * q4 + j) * 136 + nt * 16 + l15] = f2bf(Sacc[nt][j] * em); }
            { const int mt = w >> 1, n0 = (w & 1) * 2; f32x4 sc0 = (f32x4){0.f, 0.f, 0.f, 0.f}, sc1 = sc0;
#pragma unroll
              for (int k = 0; k < 4; ++k) { const bf16x8 av = *(const LAS bf16x8*)(QS + (mt * 16 + l15) * 136 + k * 32 + 8 * q4);
                  const bf16x8 b0 = *(const LAS bf16x8*)(KS + (n0 * 16 + l15) * 136 + k * 32 + 8 * q4), b1 = *(const LAS bf16x8*)(KS + ((n0 + 1) * 16 + l15) * 136 + k * 32 + 8 * q4);
                  sc0 = __builtin_amdgcn_mfma_f32_16x16x32_bf16(av, b0, sc0, 0, 0, 0); sc1 = __builtin_amdgcn_mfma_f32_16x16x32_bf16(av, b1, sc1, 0, 0, 0); }
#pragma unroll
              for (int j = 0; j < 4; ++j) { const int t = mt * 16 + 4 * q4 + j, s0 = n0 * 16 + l15, s1 = s0 + 16;
                  Pm[t * 72 + s0] = (s0 <= t) ? f2bf(sc0[j]) : (bf16_t)0; Pm[t * 72 + s1] = (s1 <= t) ? f2bf(sc1[j]) : (bf16_t)0; } }
            __syncthreads();
#pragma unroll
            for (int m4 = 0; m4 < 4; ++m4) oacc[m4] = (f32x4){0.f, 0.f, 0.f, 0.f};
#pragma unroll
            for (int k = 0; k < 2; ++k) { const bf16x8 bv = *(const LAS bf16x8*)(Vt + (16 * w + l15) * 72 + k * 32 + 8 * q4);
#pragma unroll
                for (int m4 = 0; m4 < 4; ++m4) { const bf16x8 av = *(const LAS bf16x8*)(Pm + (m4 * 16 + l15) * 72 + k * 32 + 8 * q4); oacc[m4] = __builtin_amdgcn_mfma_f32_16x16x32_bf16(av, bv, oacc[m4], 0, 0, 0); } }
#pragma unroll
            for (int k = 0; k < 4; ++k) { const bf16x8 bv = *(const LAS bf16x8*)(St + (16 * w + l15) * 136 + k * 32 + 8 * q4);
#pragma unroll
                for (int m4 = 0; m4 < 4; ++m4) { const bf16x8 av = *(const LAS bf16x8*)(QS + (m4 * 16 + l15) * 136 + k * 32 + 8 * q4); oacc[m4] = __builtin_amdgcn_mfma_f32_16x16x32_bf16(av, bv, oacc[m4], 0, 0, 0); } }
        } else if (more) {
#pragma unroll
            for (int k = 0; k < 2; ++k) { *(LAS u32x4*)(RF + roff + k * 4096) = pf_f[k]; *(LAS u32x4*)(RV + roff + k * 4096) = pf_v[k]; }
        }
        {
            f32x4 kv[8];
#pragma unroll
            for (int nt = 0; nt < 8; ++nt) kv[nt] = (f32x4){0.f, 0.f, 0.f, 0.f};
#pragma unroll
            for (int k = 0; k < 2; ++k) { const bf16x8 av = *(const LAS bf16x8*)(Vt + (16 * w + l15) * 72 + k * 32 + 8 * q4);
#pragma unroll
                for (int nt = 0; nt < 8; ++nt) { const bf16x8 bv = *(const LAS bf16x8*)(KSt + (nt * 16 + l15) * 72 + k * 32 + 8 * q4); kv[nt] = __builtin_amdgcn_mfma_f32_16x16x32_bf16(av, bv, kv[nt], 0, 0, 0); } }
#pragma unroll
            for (int nt = 0; nt < 8; ++nt) { const float dec = DEC[nt * 16 + l15], el = EL[nt * 16 + l15]; Sacc[nt] = Sacc[nt] * dec + kv[nt] * el; }
        }
        if (FINAL) {
            { const u32x4* gp0 = (const u32x4*)(z + (rowbase + (tid >> 3)) * 3072 + 2560 + hd * 128 + (tid & 7) * 16); gpre[0] = gp0[0]; gpre[1] = gp0[1]; }
            __syncthreads();
#pragma unroll
            for (int m4 = 0; m4 < 4; ++m4)
#pragma unroll
                for (int j = 0; j < 4; ++j) OB[(m4 * 16 + 4 * q4 + j) * 132 + 16 * w + l15] = oacc[m4][j];
            if (more) {
#pragma unroll
                for (int k = 0; k < 2; ++k) { *(LAS u32x4*)(RF + roff + k * 4096) = pf_f[k]; *(LAS u32x4*)(RV + roff + k * 4096) = pf_v[k]; *(LAS u32x4*)(RQ + roff + k * 4096) = pf_q[k]; }
            }
            __syncthreads();
            const int t = tid >> 3, part = tid & 7; const size_t row = rowbase + t;
            f32x4 o[4]; float ss = 0.f;
#pragma unroll
            for (int i = 0; i < 4; ++i) { o[i] = *(const LAS f32x4*)(OB + t * 132 + part * 16 + i * 4); ss += (o[i][0] * o[i][0] + o[i][1] * o[i][1]) + (o[i][2] * o[i][2] + o[i][3] * o[i][3]); }
            ss += __shfl_xor(ss, 1); ss += __shfl_xor(ss, 2); ss += __shfl_xor(ss, 4);
            const float rstd = rsqrtf(ss * (1.0f / 128.0f) + 1e-6f);
            u32x4* op = (u32x4*)(mix + row * 1024 + 512 + hd * 128 + part * 16);
#pragma unroll
            for (int hh = 0; hh < 2; ++hh) { const u32x4 gw = gpre[hh]; u32x4 ow;
#pragma unroll
                for (int e = 0; e < 4; ++e) { const unsigned gword = gw[e]; const int i0 = hh * 8 + e * 2;
                    const float v0 = o[i0 >> 2][i0 & 3] * rstd * GN[part * 16 + i0] * bflo(gword);
                    const float v1 = o[(i0 + 1) >> 2][(i0 + 1) & 3] * rstd * GN[part * 16 + i0 + 1] * bfhi(gword);
                    ow[e] = cvt_pk_bf16(v0, v1); }
                op[hh] = ow; }
        } else {
            __syncthreads();
        }
    }
    if (!FINAL) {
#pragma unroll
        for (int nt = 0; nt < 8; ++nt) *(f32x4*)(HGS + (size_t)it * 16384 + (size_t)((w * 8 + nt) * 64 + lane) * 4) = Sacc[nt];
        if (sub == 0) HGD[(size_t)it * 128 + dk] = dtot;
    }
    __syncthreads();
}

template <bool FINAL> DI void phase_mixer0(LAS unsigned char* lds, const Args& a) {
#ifndef NO_HG
    for (int it = bid_(); it < 256; it += (int)gridDim.x) hgrn_item<FINAL>(lds, a, it);
#endif
#ifndef NO_LRU
    for (int it = bid_(); it < 256; it += (int)gridDim.x) lru_item<FINAL>(lds, a, it);
#endif
}

DI void phase_sgu(LAS unsigned char* lds, const Args& a) {
    const int tid = tid_(), lane = tid & 63, w = tid >> 6, c8 = tid & 15;
    const bf16_t* uv = (const bf16_t*)(a.ws + WS_UV); bf16_t* sg = (bf16_t*)(a.ws + WS_SG); const bf16_t* wsc = (const bf16_t*)(a.ws + WS_WSC); const float* vst = (const float*)(a.ws + WS_VST);
    LAS bf16_t* WC = (LAS bf16_t*)lds;
    LAS bf16_t* VnT = WC + 128 * 136;
    LAS float* MU = (LAS float*)(VnT + 128 * 136); LAS float* RS = MU + 128;
    LAS float* OT = (LAS float*)(lds + 70656);
    const int G = (int)gridDim.x;
    int cur_g = -1; float lg[8], lb8[8];
#pragma unroll
    for (int e = 0; e < 8; ++e) { lg[e] = 0.f; lb8[e] = 0.f; }
    u32x4 raw[4]; float mu_r = 0.f, rs_r = 0.f;
    int it = bid_();
    if (it < 4096) { const size_t rb = (size_t)(it >> 3) * 128; const int g = it & 7;
#pragma unroll
        for (int i = 0; i < 4; ++i) raw[i] = *(const u32x4*)(uv + (rb + (tid >> 4) + 32 * i) * 2048 + 1024 + g * 128 + c8 * 8);
        if (tid < 128) { const size_t row = rb + tid; float s1 = 0.f, s2 = 0.f;
#pragma unroll
            for (int p = 0; p < 16; ++p) { const f32x2 q = *(const f32x2*)(vst + (row * 16 + p) * 2); s1 += q[0]; s2 += q[1]; }
            mu_r = s1 * (1.0f / 1024.0f); rs_r = rsqrtf(fmaxf(s2 * (1.0f / 1024.0f) - mu_r * mu_r, 0.f) + 1e-6f); } }
    for (; it < 4096; it += G) {
        const int g = it & 7; const size_t rowbase = (size_t)(it >> 3) * 128;
        if (g != cur_g) { cur_g = g;
#pragma unroll
            for (int r = 0; r < 4; ++r) { const int e = tid + 512 * r, t = e >> 4, ch = e & 15; *(LAS u32x4*)(WC + t * 136 + ch * 8) = *(const u32x4*)(wsc + g * 16384 + t * 128 + ch * 8); }
#pragma unroll
            for (int e = 0; e < 8; ++e) { lg[e] = a.in[17][g * 128 + c8 * 8 + e]; lb8[e] = a.in[18][g * 128 + c8 * 8 + e]; } }
        if (tid < 128) { MU[tid] = mu_r; RS[tid] = rs_r; }
        u32x4 cur[4];
#pragma unroll
        for (int i = 0; i < 4; ++i) cur[i] = raw[i];
        __syncthreads();
        { const int nit = it + G;
          if (nit < 4096) { const size_t rb = (size_t)(nit >> 3) * 128; const int gn = nit & 7;
#pragma unroll
              for (int i = 0; i < 4; ++i) raw[i] = *(const u32x4*)(uv + (rb + (tid >> 4) + 32 * i) * 2048 + 1024 + gn * 128 + c8 * 8);
              if (tid < 128) { const size_t row = rb + tid; float s1 = 0.f, s2 = 0.f;
#pragma unroll
                  for (int p = 0; p < 16; ++p) { const f32x2 q = *(const f32x2*)(vst + (row * 16 + p) * 2); s1 += q[0]; s2 += q[1]; }
                  mu_r = s1 * (1.0f / 1024.0f); rs_r = rsqrtf(fmaxf(s2 * (1.0f / 1024.0f) - mu_r * mu_r, 0.f) + 1e-6f); } } }
        u32x4 uq[4];
#pragma unroll
        for (int i = 0; i < 4; ++i) uq[i] = *(const u32x4*)(uv + (rowbase + 16 * w + (lane >> 4) + 4 * i) * 2048 + g * 128 + (lane & 15) * 8);
#pragma unroll
        for (int i = 0; i < 4; ++i) { const int s = (tid >> 4) + 32 * i; const u32x4 rw = cur[i];
            const float mu = MU[s], rs = RS[s];
#pragma unroll
            for (int e = 0; e < 4; ++e) { const float v0 = (bflo(rw[e]) - mu) * rs * lg[2 * e] + lb8[2 * e], v1 = (bfhi(rw[e]) - mu) * rs * lg[2 * e + 1] + lb8[2 * e + 1];
                const int ps = ((((s >> 3) ^ c8) & 15) << 3) + (s & 7);
                VnT[(c8 * 8 + 2 * e) * 136 + ps] = f2bf(v0); VnT[(c8 * 8 + 2 * e + 1) * 136 + ps] = f2bf(v1); } }
        __syncthreads();
        f32x4 acc[8];
#pragma unroll
        for (int nt = 0; nt < 8; ++nt) acc[nt] = (f32x4){0.f, 0.f, 0.f, 0.f};
#pragma unroll
        for (int k = 0; k < 4; ++k) { const bf16x8 av = *(const LAS bf16x8*)(WC + (16 * w + (lane & 15)) * 136 + k * 32 + 8 * (lane >> 4));
#pragma unroll
            for (int nt = 0; nt < 8; ++nt) { const int cr = nt * 16 + (lane & 15); const bf16x8 bv = *(const LAS bf16x8*)(VnT + cr * 136 + ((((k * 4 + (lane >> 4)) ^ (cr >> 3)) & 15) << 3));
                acc[nt] = __builtin_amdgcn_mfma_f32_16x16x32_bf16(av, bv, acc[nt], 0, 0, 0); } }
#pragma unroll
        for (int nt = 0; nt < 8; ++nt)
#pragma unroll
            for (int j = 0; j < 4; ++j) OT[(16 * w + 4 * (lane >> 4) + j) * 132 + nt * 16 + (lane & 15)] = acc[nt][j];
        asm volatile("s_waitcnt lgkmcnt(0)" ::: "memory");
#pragma unroll
        for (int i = 0; i < 4; ++i) { const int tl = 16 * w + (lane >> 4) + 4 * i; const float bias = a.in[20][g * 128 + tl];
            const f32x4 o0 = *(const LAS f32x4*)(OT + tl * 132 + (lane & 15) * 8), o1 = *(const LAS f32x4*)(OT + tl * 132 + (lane & 15) * 8 + 4);
            const u32x4 uu = uq[i]; u32x4 ow;
            ow.x = cvt_pk_bf16(bflo(uu.x) * (o0[0] + bias), bfhi(uu.x) * (o0[1] + bias)); ow.y = cvt_pk_bf16(bflo(uu.y) * (o0[2] + bias), bfhi(uu.y) * (o0[3] + bias));
            ow.z = cvt_pk_bf16(bflo(uu.z) * (o1[0] + bias), bfhi(uu.z) * (o1[1] + bias)); ow.w = cvt_pk_bf16(bflo(uu.w) * (o1[2] + bias), bfhi(uu.w) * (o1[3] + bias));
            *(u32x4*)(sg + (rowbase + tl) * 1024 + g * 128 + (lane & 15) * 8) = ow; }
        __syncthreads();
    }
}

DI void phase_final(const Args& a) {
    const int tid = tid_(), lane = tid & 63, wave = tid >> 6;
    const int gw = bid_() * 8 + wave, NGW = (int)gridDim.x * 8;
    const float* ssq = (const float*)(a.ws + WS_SSQ); const float* gn = a.in[3]; const bf16_t* hb = (const bf16_t*)(a.ws + WS_HB);
    f32x4 gv[4];
#pragma unroll
    for (int j = 0; j < 4; ++j) gv[j] = *((const f32x4*)gn + lane + 64 * j);
    for (int m = gw; m < MTOK; m += NGW) {
        const float rs = ssq_rs(ssq, (size_t)m);
        const u32x2* hp = (const u32x2*)(hb + (size_t)m * DM) + lane; f32x4* p = (f32x4*)(a.out + (size_t)m * DM) + lane;
#pragma unroll
        for (int j = 0; j < 4; ++j) { const u32x2 r = hp[64 * j]; const f32x4 v = (f32x4){bflo(r.x), bfhi(r.x), bflo(r.y), bfhi(r.y)}; p[64 * j] = v * rs * gv[j]; }
    }
}

#define XB_TMO      128
#define XB_XCNT(j)  (256  + 64 * (j))
#define XB_XSUB(j)  (1280 + 64 * (j))
#define XB_XGEN(j)  (2304 + 64 * (j))
#define XB_TOP      3328
#define XB_TOPGEN   3392
#define XCD_BAR_WORDS 3456
#define XB_SPIN_CAP (1u << 22)
DI unsigned xb_ld(unsigned* p)              { return __hip_atomic_load(p, __ATOMIC_RELAXED, __HIP_MEMORY_SCOPE_AGENT); }
DI unsigned xb_add(unsigned* p, unsigned v) { return __hip_atomic_fetch_add(p, v, __ATOMIC_RELAXED, __HIP_MEMORY_SCOPE_AGENT); }
DI unsigned xb_xcc_id() { return (unsigned)__builtin_amdgcn_s_getreg((3 << 11) | 20) & 0xFu; }
#define XB_SPIN(cond, bar) do { unsigned _sp = 0; while (cond) { __builtin_amdgcn_s_sleep(1); \
    if ((++_sp & 255u) == 0u) { if (xb_ld(&(bar)[XB_TMO])) break; if (_sp > XB_SPIN_CAP) { atomicAdd(&(bar)[XB_TMO], 1u); break; } } } } while (0)
struct XcdBarrier { unsigned* bar; unsigned x; volatile LAS unsigned* st; };
DI XcdBarrier xcd_barrier_post(unsigned* bar, volatile LAS unsigned* st) {
    XcdBarrier b; b.bar = bar; b.x = xb_xcc_id(); b.st = st;
    if (threadIdx.x == 0) (void)xb_add(&bar[XB_XCNT(b.x)], 1u);
    return b;
}
DI void xcd_barrier_complete(unsigned* bar, unsigned x, unsigned& nloc, unsigned& nx) {
    const unsigned G = gridDim.x * gridDim.y * gridDim.z;
    unsigned sum, cnt, mine, sp = 0u;
    for (;;) {
        sum = 0u; cnt = 0u; mine = 0u;
#pragma unroll
        for (unsigned j = 0; j < 16; ++j) { const unsigned c = xb_ld(&bar[XB_XCNT(j)]); sum += c; cnt += (c > 0u) ? 1u : 0u; mine = (j == x) ? c : mine; }
        if (sum == G) break;
        __builtin_amdgcn_s_sleep(1);
        if ((++sp & 255u) == 0u) { if (xb_ld(&bar[XB_TMO])) break; if (sp > XB_SPIN_CAP) { atomicAdd(&bar[XB_TMO], 1u); break; } }
    }
    nloc = mine > 0u ? mine : 1u; nx = cnt > 0u ? cnt : 1u;
}
DI void xcd_barrier(const XcdBarrier& b) {
    asm volatile("s_waitcnt vmcnt(0)" ::: "memory");
    __syncthreads();
    if (threadIdx.x == 0) {
        unsigned* bar = b.bar;
        __builtin_amdgcn_s_waitcnt(0);
        unsigned nloc = b.st[0], nx = b.st[1];
        if (nloc == 0u) { xcd_barrier_complete(bar, b.x, nloc, nx); b.st[0] = nloc; b.st[1] = nx; }
        const unsigned old = xb_add(&bar[XB_XSUB(b.x)], 1u);
        const unsigned gen = old / nloc;
        if (old + 1u == (gen + 1u) * nloc) {
            __builtin_amdgcn_fence(__ATOMIC_RELEASE, "agent");
            asm volatile("s_waitcnt vmcnt(0)" ::: "memory");
            const unsigned og = xb_add(&bar[XB_TOP], 1u);
            const unsigned tg = og / nx;
            if (og + 1u == (tg + 1u) * nx) xb_add(&bar[XB_TOPGEN], 1u);
            else XB_SPIN(xb_ld(&bar[XB_TOPGEN]) == tg, bar);
            __builtin_amdgcn_fence(__ATOMIC_ACQUIRE, "agent");
            xb_add(&bar[XB_XGEN(b.x)], 1u);
            asm volatile("s_waitcnt vmcnt(0)" ::: "memory");
        } else {
            XB_SPIN(xb_ld(&bar[XB_XGEN(b.x)]) == gen, bar);
            __builtin_amdgcn_fence(__ATOMIC_ACQUIRE, "agent");
            asm volatile("s_waitcnt vmcnt(0)" ::: "memory");
        }
    }
    __syncthreads();
}

constexpr int NPHASE = 13;
#ifndef REP_MASK
#define REP_MASK 0
#endif
#ifndef USE_CG_SYNC
#define USE_CG_SYNC 0
#endif
#ifndef PH_MASK
#define PH_MASK 0xFFFF
#endif
#define PHM(k) (((PH_MASK) >> (k)) & 1)
__global__ void __launch_bounds__(NTHR, 2) mk_fwd(Args a) {
    extern __shared__ __attribute__((aligned(16))) unsigned char lds_raw[];
    LAS unsigned char* lds = (LAS unsigned char*)lds_raw;
    unsigned char* ws = a.ws;
    bf16_t* hb = (bf16_t*)(ws + WS_HB); float* ssq = (float*)(ws + WS_SSQ); float* H = a.out;
    volatile LAS unsigned* bst = (volatile LAS unsigned*)(lds + 131072 + 4096 + 23552);
    if (threadIdx.x < 4) bst[threadIdx.x] = 0u;
    __syncthreads();
    XcdBarrier xb = xcd_barrier_post((unsigned*)ws, bst);
    if (threadIdx.x == 0) { const unsigned xcc = xb.x & 7u; bst[2] = xcc; bst[3] = xb_add((unsigned*)ws + 4096 + 64 * xcc, 1u); }
    int vc = (int)blockIdx.x; bool vc_done = false;
    for (int pi = a.ph_lo; pi < a.ph_hi; ++pi) {
        const int ph = a.seq[pi];
        if (pi > 0 && !vc_done) {
            if (threadIdx.x == 0) { bool ok = (gridDim.x % 8u) == 0u;
                for (unsigned j = 0; j < 8; ++j) ok = ok && (xb_ld((unsigned*)ws + 4096 + 64 * j) == gridDim.x / 8u);
                bst[2] = ok ? (bst[2] + 8u * bst[3]) : blockIdx.x; }
            __syncthreads(); vc = __builtin_amdgcn_readfirstlane((int)bst[2]); vc_done = true;
        }
        if (PHM(0) && ph == 0) phase_prep(lds, a);
        else if (PHM(1) && ph == 1) { EpiScale E{(bf16_t*)(ws + WS_Z), 3072, (const LAS float*)(lds + RST_OFF)}; run_gemm<EpiScale, true>(lds, vc, hb, (const bf16_t*)(ws + WS_WIN0), MTOK, 3072, 1024, E, ssq); }
        else if (PHM(2) && ph == 2) phase_mixer0<false>(lds, a);
        else if (PHM(3) && ph == 3) phase_mixer0<true>(lds, a);
        else if (PHM(4) && (ph == 4 || ph == 9)) {
            EpiRes E{hb, ssq};
            run_gemm(lds, vc, (const bf16_t*)(ws + (ph == 4 ? WS_MIX : WS_SG)), (const bf16_t*)(ws + (ph == 4 ? WS_WOUT0 : WS_WOUT1)), MTOK, 1024, 1024, E);
        }
        else if (PHM(5) && ph == 7) { EpiGelu E{(bf16_t*)(ws + WS_UV), 2048, (const LAS float*)(lds + RST_OFF), a.in[16], (float*)(ws + WS_VST)}; run_gemm(lds, vc, hb, (const bf16_t*)(ws + WS_WIN1), MTOK, 2048, 1024, E, ssq); }
        else if (PHM(6) && ph == 8) phase_sgu(lds, a);
        else if (PHM(7) && ph == 12) phase_final(a);
        else if (PHM(8) && (ph == 5 || ph == 10)) {
            const int layer = (ph == 10);
            EpiFfn E{(bf16_t*)(ws + WS_ACT), (const LAS float*)(lds + RST_OFF), a.in[23] + (size_t)layer * 3 * DFF, a.in[24] + (size_t)layer * DFF, (LAS float*)(lds + 131072)};
            run_gemm_ffn(lds, vc, hb, (const bf16_t*)(ws + (layer ? WS_WUP1 : WS_WUP0)), ssq, E);
        }
        else if (PHM(9) && (ph == 6 || ph == 11)) {
            const int layer = (ph == 11);
            EpiRes E{hb, ssq}; run_gemm(lds, vc, (const bf16_t*)(ws + WS_ACT), (const bf16_t*)(ws + (layer ? WS_WDN1 : WS_WDN0)), MTOK, 1024, DFF, E);
        }
        if (pi + 1 < a.ph_hi) {
            if (USE_CG_SYNC || a.ph_hi > 1000) { __threadfence(); cg::this_grid().sync(); }
            else xcd_barrier(xb);
        }
    }
}

extern "C" void kernel_launch(void* const* d_in, const int* in_sizes, int n_in, void* d_out, int out_size, void* d_ws, size_t ws_size, hipStream_t stream) {
    static int grid = 0;
    if (grid == 0) {
        if (n_in != 26 || ws_size < WS_END) { fprintf(stderr, "kernel_launch: unexpected n_in %d / ws_size %zu (need %zu)\n", n_in, ws_size, (size_t)WS_END); grid = -1; return; }
        int dev = 0, cus = 0, per_cu = 0;
        (void)hipGetDevice(&dev); (void)hipDeviceGetAttribute(&cus, hipDeviceAttributeMultiprocessorCount, dev);
        if (hipFuncSetAttribute((const void*)mk_fwd, hipFuncAttributeMaxDynamicSharedMemorySize, LDS_BYTES) != hipSuccess) { fprintf(stderr, "kernel_launch: hipFuncSetAttribute failed\n"); grid = -1; return; }
        if (hipOccupancyMaxActiveBlocksPerMultiprocessor(&per_cu, (const void*)mk_fwd, NTHR, LDS_BYTES) != hipSuccess || per_cu < 1) { fprintf(stderr, "kernel_launch: occupancy query gave %d\n", per_cu); per_cu = 1; }
        (void)hipGetLastError();
        grid = cus * per_cu;
    }
    if (grid < 0) return;
    Args a{};
    for (int i = 0; i < 26; ++i) a.in[i] = (const float*)d_in[i];
    a.out = (float*)d_out; a.ws = (unsigned char*)d_ws;
#if ONE_LAUNCH
    { int n = 0; for (int ph = 0; ph < NPHASE; ++ph) { a.seq[n++] = ph; if ((REP_MASK >> ph) & 1) a.seq[n++] = ph; } a.ph_lo = 0; a.ph_hi = n; }
    if (hipMemsetAsync(d_ws, 0, 32768, stream) != hipSuccess) { fprintf(stderr, "kernel_launch: memset of the barrier words failed\n"); return; }
    void* args[] = {&a};
    hipError_t e = hipLaunchCooperativeKernel((const void*)mk_fwd, dim3(grid), dim3(NTHR), args, LDS_BYTES, stream);
    if (e != hipSuccess) fprintf(stderr, "cooperative launch failed: %s (grid %d)\n", hipGetErrorString(e), grid);
#else
    for (int ph = 0; ph < NPHASE; ++ph) {
        a.seq[0] = ph; a.ph_lo = 0; a.ph_hi = 1;
        hipLaunchKernelGGL(mk_fwd, dim3(grid), dim3(NTHR), LDS_BYTES, stream, a);
    }
#endif
}
```

```cpp
#include <hip/hip_runtime.h>
#include <hip/hip_cooperative_groups.h>
#include <cstdio>
namespace cg = cooperative_groups;

#ifndef ONE_LAUNCH
#define ONE_LAUNCH 1
#endif

#define LAS __attribute__((address_space(3)))
#define DI __device__ __forceinline__
typedef unsigned short bf16_t;
typedef short bf16x8 __attribute__((ext_vector_type(8)));
typedef float f32x4 __attribute__((ext_vector_type(4)));
typedef float f32x2 __attribute__((ext_vector_type(2)));
typedef unsigned u32x4 __attribute__((ext_vector_type(4)));
typedef unsigned u32x2 __attribute__((ext_vector_type(2)));

constexpr int MTOK = 65536, DM = 1024, TSEQ = 8192, NBATCH = 8, DFF = 2816;
constexpr int LDS_BYTES = 131072 + 4096 + 23552 + 16;
constexpr int NTHR = 512;

constexpr size_t MiB = 1024ull * 1024ull;
constexpr size_t WS_WIN0 = 1 * MiB;
constexpr size_t WS_WOUT0 = WS_WIN0 + 6 * MiB;
constexpr size_t WS_WUP0 = WS_WOUT0 + 2 * MiB;
constexpr size_t WS_WDN0 = WS_WUP0 + 11 * MiB;
constexpr size_t WS_WIN1 = WS_WDN0 + 11 * MiB / 2;
constexpr size_t WS_WOUT1 = WS_WIN1 + 4 * MiB;
constexpr size_t WS_WUP1 = WS_WOUT1 + 2 * MiB;
constexpr size_t WS_WDN1 = WS_WUP1 + 11 * MiB;
constexpr size_t WS_WSC = 48 * MiB;
constexpr size_t WS_SSQ = 49 * MiB;
constexpr size_t WS_VST = 53 * MiB;
constexpr size_t WS_LRUAGG = 61 * MiB;
constexpr size_t WS_HGD = 62 * MiB;
constexpr size_t WS_HGS = 63 * MiB;
constexpr size_t WS_HB = 80 * MiB;
constexpr size_t WS_R1 = 208 * MiB;
constexpr size_t WS_Z = WS_R1;
constexpr size_t WS_MIX = WS_R1 + 384 * MiB;
constexpr size_t WS_ACT = WS_R1;
constexpr size_t WS_UV = WS_R1;
constexpr size_t WS_SG = WS_R1 + 384 * MiB;
constexpr size_t WS_END = WS_R1 + 528 * MiB;

struct Args { const float* in[26]; float* out; unsigned char* ws; int ph_lo, ph_hi; int seq[32]; };

typedef __bf16 bf16x2_t __attribute__((ext_vector_type(2)));
DI unsigned cvt_pk_bf16(float lo, float hi) { const bf16x2_t v = __builtin_convertvector((f32x2){lo, hi}, bf16x2_t); return __builtin_bit_cast(unsigned, v); }
DI bf16_t f2bf(float f) { return (bf16_t)(cvt_pk_bf16(f, 0.f) & 0xffffu); }
DI float bf2f(bf16_t b) { return __builtin_bit_cast(float, (unsigned)b << 16); }
DI float bflo(unsigned w) { return __builtin_bit_cast(float, w << 16); }
DI float bfhi(unsigned w) { return __builtin_bit_cast(float, w & 0xffff0000u); }
DI int tid_() { int t = (int)threadIdx.x; asm volatile("" : "+v"(t)); return t; }
DI int bid_() { int b = __builtin_amdgcn_workgroup_id_x(); asm volatile("" : "+s"(b)); return b; }
DI float sigmoidf_(float x) { return __builtin_amdgcn_rcpf(1.0f + __builtin_amdgcn_exp2f(x * -1.44269504f)); }
DI float siluf_(float x) { return x * sigmoidf_(x); }
DI float geluf_(float x) { const float y = 1.5957691216f * (x + 0.044715f * x * x * x); return x * sigmoidf_(y); }
DI float wave_sum(float v) {
#pragma unroll
    for (int o = 1; o < 64; o <<= 1) v += __shfl_xor(v, o);
    return v;
}
DI f32x4 mma16(const LAS bf16_t* A, int lda, const LAS bf16_t* Bt, int ldb, int K, f32x4 acc, int lane) {
    const LAS bf16_t* a = A + (lane & 15) * lda + 8 * (lane >> 4);
    const LAS bf16_t* b = Bt + (lane & 15) * ldb + 8 * (lane >> 4);
#pragma unroll
    for (int k = 0; k < K; k += 32) {
        const bf16x8 av = *(const LAS bf16x8*)(a + k); const bf16x8 bv = *(const LAS bf16x8*)(b + k);
        acc = __builtin_amdgcn_mfma_f32_16x16x32_bf16(av, bv, acc, 0, 0, 0);
    }
    return acc;
}

namespace pg8 {
constexpr int BM = 256, BK = 64, HALF = 128, HTB = HALF * BK * 2, STAGE_BYTES = 8 * HTB, NXCD = 8, WGM = 8;
DI int lds_byte(int r, int c) { const int st = (r >> 4) * 2 + (c >> 5), rr = r & 15, cc = c & 31, ob = rr * 64 + cc * 2; return st * 1024 + (ob ^ (((ob >> 9) & 1) << 5)); }
DI void stage_rc(int b, int& R, int& C) { const int st = b / 1024, sb = b % 1024, swz = sb ^ (((sb >> 9) & 1) << 5); R = (st >> 1) * 16 + swz / 64; C = (st & 1) * 32 + (swz % 64) / 2; }
DI int perm32(int rho) { const int n = rho >> 4, i = rho & 15; return 8 * (i >> 2) + 4 * n + (i & 3); }
struct Unit { int pm, pn, arow, ord; };
struct Gemm { const bf16_t* A; const bf16_t* Bt; int M, N, K; };
struct StaticOrder {
    int nM, nN, nwg, G, c, ffn;
    DI void init(int M, int N, int G_, int c_) { nM = M / BM; nN = N / BM; nwg = nM * nN; G = G_; c = c_; ffn = 0; }
    DI void init_ffn(int G_, int c_) { nM = 264; nN = 22; nwg = nM * nN; G = G_; c = c_; ffn = 1; }
    DI bool next(int i, Unit& u) const {
        const long L = (long)i * G + c; if (L >= nwg) return false;
        int wgid = (int)L; { const int q = nwg / NXCD, r = nwg % NXCD, xcd = wgid % NXCD, off = wgid / NXCD; wgid = (xcd < r ? xcd * (q + 1) : r * (q + 1) + (xcd - r) * q) + off; }
        const int nig = WGM * nN, gid = wgid / nig, fm = gid * WGM, gsz = (nM - fm) < WGM ? (nM - fm) : WGM;
        u.pm = fm + ((wgid % nig) % gsz); u.pn = (wgid % nig) / gsz;
        if (ffn) { const int bb = u.pm / 33, ii = u.pm - bb * 33; u.arow = bb * 8192 + ii * 254 - 2; } else u.arow = u.pm * BM;
        return true;
    }
};

template <class Epi>
DI void gemm_phase(LAS unsigned char* lds, const Gemm g, const StaticOrder& S, const Epi& E) {
    const int tid = tid_(), wid = __builtin_amdgcn_readfirstlane(tid >> 6), lane = tid & 63, wr = wid >> 2, wc = wid & 3, fr = lane & 15, fq = lane >> 4;
    const int K = g.K, nt = K / BK;
    unsigned voffA[2], voffB[2];
#pragma unroll
    for (int i = 0; i < 2; ++i) { int R, C; stage_rc(tid * 16 + i * 8192, R, C); const int Rb = Epi::PERM ? ((R & ~31) + perm32(R & 31)) : R;
        voffA[i] = (unsigned)(R * K + C) * 2u; voffB[i] = (unsigned)(Rb * K + C) * 2u; }
    const size_t kstep = (size_t)(BK * 2);
    const size_t hstep = (size_t)HALF * K * 2;
    const size_t tstep = 2 * hstep;
    const unsigned ldsw = (unsigned)wid * 1024u;
    const int aoff = lds_byte(wr * 64 + fr, fq * 8), boff = lds_byte(wc * 32 + fr, fq * 8);
#define PG8_SA(b, h) (((b) * 2 + (h)) * HTB)
#define PG8_SB(b, h) ((4 + (b) * 2 + (h)) * HTB)
#define PG8_STAGE(bufoff, gbase, voff) do { _Pragma("unroll") for (int _i = 0; _i < 2; ++_i) \
        __builtin_amdgcn_global_load_lds((const unsigned*)((const char*)(gbase) + (voff)[_i]), (LAS unsigned*)(lds + (bufoff) + ldsw + _i * 8192), 16, 0, 0); } while (0)
#define PG8_LDA(dst, b, h) do { _Pragma("unroll") for (int m = 0; m < 4; ++m) _Pragma("unroll") for (int k = 0; k < 2; ++k) dst[m][k] = *(const LAS bf16x8*)(lds + PG8_SA(b, h) + aoff + m * 2048 + k * 1024); } while (0)
#define PG8_LDB(dst, b, h) do { _Pragma("unroll") for (int n = 0; n < 2; ++n) _Pragma("unroll") for (int k = 0; k < 2; ++k) dst[n][k] = *(const LAS bf16x8*)(lds + PG8_SB(b, h) + boff + n * 2048 + k * 1024); } while (0)
#define PG8_MMA(ai, bj, At, Bt) do { __builtin_amdgcn_s_setprio(1); _Pragma("unroll") for (int m = 0; m < 4; ++m) _Pragma("unroll") for (int n = 0; n < 2; ++n) _Pragma("unroll") for (int k = 0; k < 2; ++k) \
        acc[ai][bj][m][n] = __builtin_amdgcn_mfma_f32_16x16x32_bf16(Bt[n][k], At[m][k], acc[ai][bj][m][n], 0, 0, 0); __builtin_amdgcn_s_setprio(0); } while (0)
#define PG8_WAIT_V(n) asm volatile("s_waitcnt vmcnt(" #n ")" ::: "memory")
#define PG8_WAIT_L(n) asm volatile("s_waitcnt lgkmcnt(" #n ")" ::: "memory")
#define PG8_BAR __builtin_amdgcn_s_barrier()
#define PG8_SCHED __builtin_amdgcn_sched_barrier(0)
    Unit cur, nxt; nxt.pm = 0; nxt.pn = 0; nxt.arow = 0; nxt.ord = 0; int ui = 0;
    if (!S.next(0, cur)) return;
    cur.ord = 0;
    f32x4 acc[2][2][4][2];
#pragma unroll
    for (int a = 0; a < 2; ++a)
#pragma unroll
        for (int b = 0; b < 2; ++b)
#pragma unroll
            for (int m = 0; m < 4; ++m)
#pragma unroll
                for (int n = 0; n < 2; ++n) acc[a][b][m][n] = (f32x4){0.f, 0.f, 0.f, 0.f};
    bf16x8 At[4][2], B0[2][2], B1[2][2];
    const char* cA = (const char*)g.A + (ptrdiff_t)cur.arow * (ptrdiff_t)(K * 2); const char* cB = (const char*)g.Bt + (size_t)cur.pn * tstep;
    PG8_STAGE(PG8_SB(0, 0), cB, voffB); PG8_STAGE(PG8_SA(0, 0), cA, voffA); PG8_STAGE(PG8_SB(0, 1), cB + hstep, voffB); PG8_STAGE(PG8_SA(0, 1), cA + hstep, voffA);
    if (wr == 1) PG8_BAR;
    PG8_WAIT_V(4); PG8_BAR;
    PG8_STAGE(PG8_SB(1, 0), cB + kstep, voffB); PG8_STAGE(PG8_SA(1, 0), cA + kstep, voffA); PG8_STAGE(PG8_SB(1, 1), cB + hstep + kstep, voffB);
    PG8_WAIT_V(6); PG8_BAR;
    for (;;) {
        const bool has_next = S.next(ui + 1, nxt); nxt.ord = ui + 1;
        const char* nA = has_next ? (const char*)g.A + (ptrdiff_t)nxt.arow * (ptrdiff_t)(K * 2) : cA; const char* nB = has_next ? (const char*)g.Bt + (size_t)nxt.pn * tstep : cB;
        for (int t = 0; t < nt; t += 2) {
            const bool last = (t == nt - 2);
            const char* a1 = cA + (size_t)(t + 1) * kstep;
            const char* a2 = last ? nA : cA + (size_t)(t + 2) * kstep; const char* b2 = last ? nB : cB + (size_t)(t + 2) * kstep;
            const char* a3 = a2 + kstep; const char* b3 = b2 + kstep;
            PG8_LDB(B0, 0, 0); PG8_SCHED; PG8_LDA(At, 0, 0); PG8_STAGE(PG8_SA(1, 1), a1 + hstep, voffA);
            PG8_WAIT_L(8); PG8_BAR; PG8_WAIT_L(0); PG8_MMA(0, 0, At, B0); PG8_BAR; PG8_SCHED;
            PG8_LDB(B1, 0, 1); PG8_STAGE(PG8_SB(0, 0), b2, voffB);
            PG8_BAR; PG8_WAIT_L(0); PG8_MMA(0, 1, At, B1); PG8_BAR;
            PG8_LDA(At, 0, 1); PG8_STAGE(PG8_SA(0, 0), a2, voffA);
            PG8_BAR; PG8_WAIT_L(0); PG8_MMA(1, 0, At, B0); PG8_BAR; PG8_SCHED;
            PG8_STAGE(PG8_SB(0, 1), b2 + hstep, voffB);
            PG8_WAIT_V(6); PG8_BAR; PG8_MMA(1, 1, At, B1); PG8_BAR;
            PG8_LDB(B0, 1, 0); PG8_SCHED; PG8_LDA(At, 1, 0); PG8_STAGE(PG8_SA(0, 1), a2 + hstep, voffA);
            PG8_WAIT_L(8); PG8_BAR; PG8_WAIT_L(0); PG8_MMA(0, 0, At, B0); PG8_BAR; PG8_SCHED;
            PG8_LDB(B1, 1, 1); PG8_STAGE(PG8_SB(1, 0), b3, voffB);
            PG8_BAR; PG8_WAIT_L(0); PG8_MMA(0, 1, At, B1); PG8_BAR;
            PG8_LDA(At, 1, 1); PG8_STAGE(PG8_SA(1, 0), a3, voffA);
            PG8_BAR; PG8_WAIT_L(0); PG8_MMA(1, 0, At, B0); PG8_BAR; PG8_SCHED;
            PG8_STAGE(PG8_SB(1, 1), b3 + hstep, voffB);
            PG8_WAIT_V(6); PG8_BAR; PG8_MMA(1, 1, At, B1); PG8_BAR;
        }
        E(acc, cur, wr, wc, fr, fq);
        if (!has_next) break;
#pragma unroll
        for (int a = 0; a < 2; ++a)
#pragma unroll
            for (int b = 0; b < 2; ++b)
#pragma unroll
                for (int m = 0; m < 4; ++m)
#pragma unroll
                    for (int n = 0; n < 2; ++n) acc[a][b][m][n] = (f32x4){0.f, 0.f, 0.f, 0.f};
        cur = nxt; cA = nA; cB = nB; ++ui;
    }
    PG8_WAIT_V(0);
    if (wr == 0) PG8_BAR;
    PG8_BAR;
#undef PG8_SA
#undef PG8_SB
#undef PG8_STAGE
#undef PG8_LDA
#undef PG8_LDB
#undef PG8_MMA
#undef PG8_WAIT_V
#undef PG8_WAIT_L
#undef PG8_BAR
#undef PG8_SCHED
}
template <class Epi>
DI void gemm_phase4(LAS unsigned char* lds, const Gemm g, const StaticOrder& S, const Epi& E) {
    const int tid = tid_(), wid = __builtin_amdgcn_readfirstlane(tid >> 6), lane = tid & 63, wr = wid >> 2, wc = wid & 3, fr = lane & 15, fq = lane >> 4;
    const int K = g.K, nt = K / BK;
    unsigned voffA[2], voffB[2];
#pragma unroll
    for (int i = 0; i < 2; ++i) { int R, C; stage_rc(tid * 16 + i * 8192, R, C); const int Rb = Epi::PERM ? ((R & ~31) + perm32(R & 31)) : R;
        voffA[i] = (unsigned)(R * K + C) * 2u; voffB[i] = (unsigned)(Rb * K + C) * 2u; }
    const size_t kstep = (size_t)(BK * 2);
    const size_t hstep = (size_t)HALF * K * 2;
    const size_t tstep = 2 * hstep;
    const unsigned ldsw = (unsigned)wid * 1024u;
    const int aoff = lds_byte(wr * 64 + fr, fq * 8), boff = lds_byte(wc * 32 + fr, fq * 8);
#define PG8_SA(b, h) (((b) * 2 + (h)) * HTB)
#define PG8_SB(b, h) ((4 + (b) * 2 + (h)) * HTB)
#define PG8_STAGE(bufoff, gbase, voff) do { _Pragma("unroll") for (int _i = 0; _i < 2; ++_i) \
        __builtin_amdgcn_global_load_lds((const unsigned*)((const char*)(gbase) + (voff)[_i]), (LAS unsigned*)(lds + (bufoff) + ldsw + _i * 8192), 16, 0, 0); } while (0)
#define PG8_LDA(dst, b, h) do { _Pragma("unroll") for (int m = 0; m < 4; ++m) _Pragma("unroll") for (int k = 0; k < 2; ++k) dst[m][k] = *(const LAS bf16x8*)(lds + PG8_SA(b, h) + aoff + m * 2048 + k * 1024); } while (0)
#define PG8_LDB(dst, b, h) do { _Pragma("unroll") for (int n = 0; n < 2; ++n) _Pragma("unroll") for (int k = 0; k < 2; ++k) dst[n][k] = *(const LAS bf16x8*)(lds + PG8_SB(b, h) + boff + n * 2048 + k * 1024); } while (0)
#define PG8_MMA(ai, bj, At, Bt) do { __builtin_amdgcn_s_setprio(1); _Pragma("unroll") for (int m = 0; m < 4; ++m) _Pragma("unroll") for (int n = 0; n < 2; ++n) _Pragma("unroll") for (int k = 0; k < 2; ++k) \
        acc[ai][bj][m][n] = __builtin_amdgcn_mfma_f32_16x16x32_bf16(Bt[n][k], At[m][k], acc[ai][bj][m][n], 0, 0, 0); __builtin_amdgcn_s_setprio(0); } while (0)
#define PG8_WAIT_V(n) asm volatile("s_waitcnt vmcnt(" #n ")" ::: "memory")
#define PG8_WAIT_L(n) asm volatile("s_waitcnt lgkmcnt(" #n ")" ::: "memory")
#define PG8_BAR __builtin_amdgcn_s_barrier()
#define PG8_SCHED __builtin_amdgcn_sched_barrier(0)
    Unit cur, nxt; nxt.pm = 0; nxt.pn = 0; nxt.arow = 0; nxt.ord = 0; int ui = 0;
    if (!S.next(0, cur)) return;
    cur.ord = 0;
    f32x4 acc[2][2][4][2];
#pragma unroll
    for (int a = 0; a < 2; ++a)
#pragma unroll
        for (int b = 0; b < 2; ++b)
#pragma unroll
            for (int m = 0; m < 4; ++m)
#pragma unroll
                for (int n = 0; n < 2; ++n) acc[a][b][m][n] = (f32x4){0.f, 0.f, 0.f, 0.f};
    bf16x8 At[4][2], B0[2][2], B1[2][2];
    const char* cA = (const char*)g.A + (ptrdiff_t)cur.arow * (ptrdiff_t)(K * 2); const char* cB = (const char*)g.Bt + (size_t)cur.pn * tstep;
    PG8_STAGE(PG8_SB(0, 0), cB, voffB); PG8_STAGE(PG8_SA(0, 0), cA, voffA); PG8_STAGE(PG8_SB(0, 1), cB + hstep, voffB); PG8_STAGE(PG8_SA(0, 1), cA + hstep, voffA);
    if (wr == 1) PG8_BAR;
    PG8_WAIT_V(0); PG8_BAR;
    PG8_STAGE(PG8_SB(1, 0), cB + kstep, voffB); PG8_STAGE(PG8_SA(1, 0), cA + kstep, voffA); PG8_STAGE(PG8_SB(1, 1), cB + hstep + kstep, voffB);
    PG8_BAR;
    for (;;) {
        const bool has_next = S.next(ui + 1, nxt); nxt.ord = ui + 1;
        const char* nA = has_next ? (const char*)g.A + (ptrdiff_t)nxt.arow * (ptrdiff_t)(K * 2) : cA; const char* nB = has_next ? (const char*)g.Bt + (size_t)nxt.pn * tstep : cB;
        for (int t = 0; t < nt; t += 2) {
            const bool last = (t == nt - 2);
            const char* a1 = cA + (size_t)(t + 1) * kstep;
            const char* a2 = last ? nA : cA + (size_t)(t + 2) * kstep; const char* b2 = last ? nB : cB + (size_t)(t + 2) * kstep;
            const char* a3 = a2 + kstep; const char* b3 = b2 + kstep;
            PG8_LDB(B0, 0, 0); PG8_LDB(B1, 0, 1); PG8_LDA(At, 0, 0); PG8_STAGE(PG8_SA(1, 1), a1 + hstep, voffA);
            PG8_WAIT_V(8); PG8_WAIT_L(0); PG8_BAR; PG8_MMA(0, 0, At, B0); PG8_MMA(0, 1, At, B1); PG8_BAR; PG8_SCHED;
            PG8_LDA(At, 0, 1); PG8_STAGE(PG8_SB(0, 0), b2, voffB); PG8_STAGE(PG8_SA(0, 0), a2, voffA); PG8_STAGE(PG8_SB(0, 1), b2 + hstep, voffB);
            PG8_WAIT_V(8); PG8_WAIT_L(0); PG8_BAR; PG8_MMA(1, 0, At, B0); PG8_MMA(1, 1, At, B1); PG8_BAR; PG8_SCHED;
            PG8_LDB(B0, 1, 0); PG8_LDB(B1, 1, 1); PG8_LDA(At, 1, 0); PG8_STAGE(PG8_SA(0, 1), a2 + hstep, voffA);
            PG8_WAIT_V(8); PG8_WAIT_L(0); PG8_BAR; PG8_MMA(0, 0, At, B0); PG8_MMA(0, 1, At, B1); PG8_BAR; PG8_SCHED;
            PG8_LDA(At, 1, 1); PG8_STAGE(PG8_SB(1, 0), b3, voffB); PG8_STAGE(PG8_SA(1, 0), a3, voffA); PG8_STAGE(PG8_SB(1, 1), b3 + hstep, voffB);
            PG8_WAIT_V(8); PG8_WAIT_L(0); PG8_BAR; PG8_MMA(1, 0, At, B0); PG8_MMA(1, 1, At, B1); PG8_BAR; PG8_SCHED;
        }
        E(acc, cur, wr, wc, fr, fq);
        if (!has_next) break;
#pragma unroll
        for (int a = 0; a < 2; ++a)
#pragma unroll
            for (int b = 0; b < 2; ++b)
#pragma unroll
                for (int m = 0; m < 4; ++m)
#pragma unroll
                    for (int n = 0; n < 2; ++n) acc[a][b][m][n] = (f32x4){0.f, 0.f, 0.f, 0.f};
        cur = nxt; cA = nA; cB = nB; ++ui;
    }
    PG8_WAIT_V(0);
    if (wr == 0) PG8_BAR;
    PG8_BAR;
#undef PG8_SA
#undef PG8_SB
#undef PG8_STAGE
#undef PG8_LDA
#undef PG8_LDB
#undef PG8_MMA
#undef PG8_WAIT_V
#undef PG8_WAIT_L
#undef PG8_BAR
#undef PG8_SCHED
}
}

DI float ssq_rs(const float* ssq, size_t row) {
    const f32x4* q = (const f32x4*)(ssq + row * 16);
    const f32x4 a = q[0], b = q[1], c = q[2], d = q[3];
    const float s = (((a[0] + a[1]) + (a[2] + a[3])) + ((b[0] + b[1]) + (b[2] + b[3]))) + (((c[0] + c[1]) + (c[2] + c[3])) + ((d[0] + d[1]) + (d[2] + d[3])));
    return rsqrtf(s * (1.0f / 1024.0f) + 1e-6f);
}

constexpr int RST_OFF = 131072 + 4096, RST_MAXU = 23;
DI void build_rstab(LAS unsigned char* lds, const pg8::StaticOrder& S, const float* ssq, int row_max) {
    LAS float* RST = (LAS float*)(lds + RST_OFF);
    const int tid = tid_(), r = tid & 255, par = tid >> 8;
    for (int i = par; i < RST_MAXU; i += 2) { pg8::Unit u; if (!S.next(i, u)) break;
        int grow = u.arow + r; grow = grow < 0 ? 0 : (grow > row_max ? row_max : grow);
        RST[i * 256 + r] = ssq_rs(ssq, (size_t)grow); }
    __syncthreads();
}
struct EpiScale {
    static constexpr bool PERM = true;
    bf16_t* O; int ldc; const LAS float* RST;
    DI void operator()(const f32x4 (&acc)[2][2][4][2], const pg8::Unit& u, int wr, int wc, int fr, int fq) const {
        const int row0 = u.pm * 256 + wr * 64 + fr, col0 = u.pn * 256 + wc * 32 + 8 * fq;
        const int tsel = u.pn >> 1; const int actsel = (tsel == 0) ? 1 : ((tsel == 2 || tsel == 5) ? 2 : 0);
#pragma unroll
        for (int ai = 0; ai < 2; ++ai)
#pragma unroll
            for (int m = 0; m < 4; ++m) {
                const size_t row = (size_t)(row0 + ai * 128 + m * 16); const float rs = RST[u.ord * 256 + wr * 64 + fr + ai * 128 + m * 16];
                bf16_t* rowp = O + row * ldc + col0;
#pragma unroll
                for (int bj = 0; bj < 2; ++bj) { f32x4 v0 = acc[ai][bj][m][0] * rs, v1 = acc[ai][bj][m][1] * rs;
                    if (actsel == 1) {
#pragma unroll
                        for (int j = 0; j < 4; ++j) { v0[j] = geluf_(v0[j]); v1[j] = geluf_(v1[j]); } }
                    else if (actsel == 2) {
#pragma unroll
                        for (int j = 0; j < 4; ++j) { v0[j] = siluf_(v0[j]); v1[j] = siluf_(v1[j]); } }
                    u32x4 w; w.x = cvt_pk_bf16(v0[0], v0[1]); w.y = cvt_pk_bf16(v0[2], v0[3]); w.z = cvt_pk_bf16(v1[0], v1[1]); w.w = cvt_pk_bf16(v1[2], v1[3]);
                    *(u32x4*)(rowp + bj * 128) = w; }
            }
    }
};
struct EpiGelu {
    static constexpr bool PERM = true;
    bf16_t* O; int ldc; const LAS float* RST; const float* bias; float* vst;
    DI void operator()(const f32x4 (&acc)[2][2][4][2], const pg8::Unit& u, int wr, int wc, int fr, int fq) const {
        const int row0 = u.pm * 256 + wr * 64 + fr, col0 = u.pn * 256 + wc * 32 + 8 * fq;
        f32x4 bv[2][2];
#pragma unroll
        for (int bj = 0; bj < 2; ++bj)
#pragma unroll
            for (int n = 0; n < 2; ++n) bv[bj][n] = *(const f32x4*)(bias + col0 + bj * 128 + 4 * n);
#pragma unroll
        for (int ai = 0; ai < 2; ++ai)
#pragma unroll
            for (int m = 0; m < 4; ++m) {
                const size_t row = (size_t)(row0 + ai * 128 + m * 16); const float rs = RST[u.ord * 256 + wr * 64 + fr + ai * 128 + m * 16];
                bf16_t* rowp = O + row * ldc + col0; float s1 = 0.f, s2 = 0.f;
#pragma unroll
                for (int bj = 0; bj < 2; ++bj) { f32x4 v0 = acc[ai][bj][m][0] * rs + bv[bj][0], v1 = acc[ai][bj][m][1] * rs + bv[bj][1];
#pragma unroll
                    for (int j = 0; j < 4; ++j) { v0[j] = geluf_(v0[j]); v1[j] = geluf_(v1[j]); s1 += v0[j] + v1[j]; s2 += v0[j] * v0[j] + v1[j] * v1[j]; }
                    u32x4 w; w.x = cvt_pk_bf16(v0[0], v0[1]); w.y = cvt_pk_bf16(v0[2], v0[3]); w.z = cvt_pk_bf16(v1[0], v1[1]); w.w = cvt_pk_bf16(v1[2], v1[3]);
                    *(u32x4*)(rowp + bj * 128) = w; }
                if (u.pn >= 4) {
                    s1 += __shfl_xor(s1, 16); s1 += __shfl_xor(s1, 32); s2 += __shfl_xor(s2, 16); s2 += __shfl_xor(s2, 32);
                    if (fq == 0) *(f32x2*)(vst + (row * 16 + (size_t)((u.pn - 4) * 4 + wc)) * 2) = (f32x2){s1, s2};
                }
            }
    }
};
struct EpiRes {
    static constexpr bool PERM = false;
    bf16_t* hb; float* ssq;
    DI void operator()(const f32x4 (&acc)[2][2][4][2], const pg8::Unit& u, int wr, int wc, int fr, int fq) const {
        const int row0 = u.pm * 256 + wr * 64 + fr, col0 = u.pn * 256 + wc * 32 + 4 * fq;
#pragma unroll
        for (int ai = 0; ai < 2; ++ai) {
            u32x2 rr[4][2][2];
#pragma unroll
            for (int m = 0; m < 4; ++m) { const size_t off = (size_t)(row0 + ai * 128 + m * 16) * DM + col0;
#pragma unroll
                for (int bj = 0; bj < 2; ++bj)
#pragma unroll
                    for (int n = 0; n < 2; ++n) rr[m][bj][n] = *(const u32x2*)(hb + off + bj * 128 + n * 16); }
#pragma unroll
            for (int m = 0; m < 4; ++m) { const size_t row = (size_t)(row0 + ai * 128 + m * 16); const size_t off = row * DM + col0; float sq = 0.f;
#pragma unroll
                for (int bj = 0; bj < 2; ++bj)
#pragma unroll
                    for (int n = 0; n < 2; ++n) {
                        const u32x2 r = rr[m][bj][n]; const f32x4 v = acc[ai][bj][m][n] + (f32x4){bflo(r.x), bfhi(r.x), bflo(r.y), bfhi(r.y)};
                        u32x2 w; w.x = cvt_pk_bf16(v[0], v[1]); w.y = cvt_pk_bf16(v[2], v[3]); *(u32x2*)(hb + off + bj * 128 + n * 16) = w;
                        sq += (v[0] * v[0] + v[1] * v[1]) + (v[2] * v[2] + v[3] * v[3]);
                    }
                sq += __shfl_xor(sq, 16); sq += __shfl_xor(sq, 32);
                if (fq == 0) ssq[row * 16 + (size_t)(u.pn * 4 + wc)] = sq; }
        }
    }
};

template <int CTRL> DI float dppmov(float oldv, float src) { return __builtin_bit_cast(float, __builtin_amdgcn_update_dpp(__builtin_bit_cast(int, oldv), __builtin_bit_cast(int, src), CTRL, 0xf, 0xf, false)); }
struct EpiFfn {
    static constexpr bool PERM = true;
    bf16_t* act; const LAS float* RST; const float* cw; const float* cb; LAS float* X;
    DI void operator()(f32x4 (&acc)[2][2][4][2], const pg8::Unit& u, int wr, int wc, int fr_, int fq_) const {
        int fr = fr_, fq = fq_; asm volatile("" : "+v"(fr), "+v"(fq));
        const int bb = u.pm / 33, ii = u.pm - bb * 33; const int tok0 = ii * 254 - 2;
        const int chl = wc * 32 + 8 * fq, ch = u.pn * 128 + chl;
#pragma unroll
        for (int ai = 0; ai < 2; ++ai)
#pragma unroll
            for (int m = 0; m < 4; ++m) {
                const int r = 128 * ai + 64 * wr + 16 * m + fr, tok = tok0 + r;
                const float rs = RST[u.ord * 256 + r];
#pragma unroll
                for (int n = 0; n < 2; ++n) { acc[ai][0][m][n] = (tok >= 0) ? acc[ai][0][m][n] * rs : (f32x4){0.f, 0.f, 0.f, 0.f}; acc[ai][1][m][n] = acc[ai][1][m][n] * rs; }
            }
#pragma unroll
        for (int ai = 0; ai < 2; ++ai) { const int slot = ai * 2 + wr;
            if (fr >= 14) {
#pragma unroll
                for (int n = 0; n < 2; ++n) *(LAS f32x4*)(X + ((slot * 2 + (fr - 14)) * 128 + chl + 4 * n)) = acc[ai][0][3][n]; } }
        f32x4 w0[2], w1[2], w2[2], bv[2];
#pragma unroll
        for (int n = 0; n < 2; ++n) { w0[n] = *(const f32x4*)(cw + ch + 4 * n); w1[n] = *(const f32x4*)(cw + DFF + ch + 4 * n); w2[n] = *(const f32x4*)(cw + 2 * DFF + ch + 4 * n); bv[n] = *(const f32x4*)(cb + ch + 4 * n); }
        asm volatile("s_waitcnt lgkmcnt(0)" ::: "memory"); __builtin_amdgcn_s_barrier(); asm volatile("" ::: "memory"); __builtin_amdgcn_s_barrier(); asm volatile("" ::: "memory");
#pragma unroll
        for (int ai = 0; ai < 2; ++ai) {
            const int slot = ai * 2 + wr; f32x4 prev[2];
            { const int rowsel = (fr == 15) ? 1 : 0; const int sl = slot > 0 ? slot - 1 : 0;
#pragma unroll
              for (int n = 0; n < 2; ++n) { prev[n] = *(const LAS f32x4*)(X + ((sl * 2 + rowsel) * 128 + chl + 4 * n)); if (slot == 0) prev[n] = (f32x4){0.f, 0.f, 0.f, 0.f}; } }
#pragma unroll
            for (int m = 0; m < 4; ++m) {
                const int r = 128 * ai + 64 * wr + 16 * m + fr, tok = tok0 + r; float o[8];
#pragma unroll
                for (int n = 0; n < 2; ++n)
#pragma unroll
                    for (int j = 0; j < 4; ++j) { const float g0 = acc[ai][0][m][n][j], p = prev[n][j];
                        const float rot1 = dppmov<0x121>(p, p), rot2 = dppmov<0x122>(p, p);
                        const float g1 = dppmov<0x111>(rot1, g0), g2 = dppmov<0x112>(rot2, g0);
                        const float cv = bv[n][j] + w0[n][j] * g2 + w1[n][j] * g1 + w2[n][j] * g0;
                        o[n * 4 + j] = siluf_(cv) * acc[ai][1][m][n][j]; }
                u32x4 ow; ow.x = cvt_pk_bf16(o[0], o[1]); ow.y = cvt_pk_bf16(o[2], o[3]); ow.z = cvt_pk_bf16(o[4], o[5]); ow.w = cvt_pk_bf16(o[6], o[7]);
                if (r >= 2 && tok < TSEQ) *(u32x4*)(act + (size_t)(bb * 8192 + tok) * DFF + ch) = ow;
                prev[0] = acc[ai][0][m][0]; prev[1] = acc[ai][0][m][1];
            }
        }
    }
};

template <class Epi> DI void run_gemm_ffn(LAS unsigned char* lds, int vc, const bf16_t* A, const bf16_t* Bt, const float* ssq, const Epi& E) {
    pg8::Gemm g{A, Bt, MTOK, 5632, 1024}; pg8::StaticOrder S; S.init_ffn((int)gridDim.x, vc);
    build_rstab(lds, S, ssq, MTOK - 1);
    pg8::gemm_phase4<Epi>(lds, g, S, E);
}
template <class Epi, bool P4 = true> DI void run_gemm(LAS unsigned char* lds, int vc, const bf16_t* A, const bf16_t* Bt, int Mrows, int N, int K, const Epi& E, const float* ssq = nullptr) {
    pg8::Gemm g{A, Bt, Mrows, N, K}; pg8::StaticOrder S; S.init(Mrows, N, (int)gridDim.x, vc);
    if (ssq) build_rstab(lds, S, ssq, Mrows - 1);
    if (P4) pg8::gemm_phase4<Epi>(lds, g, S, E); else pg8::gemm_phase<Epi>(lds, g, S, E);
}

DI void transpose_item(const float* W, int K, int N, bf16_t* WT, const float* gain, LAS float* scr, int item, int lane, bool ffn_remap = false) {
    const int nblk = N / 32, kb = item / nblk, nb = item % nblk, k0 = 64 * kb, n0 = 32 * nb;
    const int r0 = ffn_remap ? ((n0 < DFF) ? (n0 / 128) * 256 + (n0 % 128) : ((n0 - DFF) / 128) * 256 + 128 + ((n0 - DFF) % 128)) : n0;
#pragma unroll 8
    for (int i = 0; i < 32; ++i) { const int kk = 2 * i + (lane >> 5); float v = W[(size_t)(k0 + kk) * N + n0 + (lane & 31)]; if (gain) v *= gain[k0 + kk]; scr[kk * 33 + (lane & 31)] = v; }
    asm volatile("s_waitcnt lgkmcnt(0)" ::: "memory");
    const int c = lane & 7;
#pragma unroll
    for (int j = 0; j < 4; ++j) { const int n = (lane >> 3) + 8 * j; const LAS float* s = scr + (8 * c) * 33 + n;
        u32x4 o; o.x = cvt_pk_bf16(s[0 * 33], s[1 * 33]); o.y = cvt_pk_bf16(s[2 * 33], s[3 * 33]); o.z = cvt_pk_bf16(s[4 * 33], s[5 * 33]); o.w = cvt_pk_bf16(s[6 * 33], s[7 * 33]);
        *(u32x4*)(WT + (size_t)(r0 + n) * K + k0 + 8 * c) = o; }
    asm volatile("s_waitcnt lgkmcnt(0)" ::: "memory");
}
DI void phase_prep(LAS unsigned char* lds, const Args& a) {
    const int tid = tid_(), lane = tid & 63, wave = tid >> 6;
    const int gw = bid_() * 8 + wave, NGW = (int)gridDim.x * 8;
    unsigned char* ws = a.ws;
    LAS float* scr = (LAS float*)(lds + wave * 8448);
    constexpr int I_IN0 = 16 * 96, I_OUT = 16 * 32, I_UP = 16 * 176, I_DN = 44 * 32, I_IN1 = 16 * 64;
    constexpr int NITEMS = I_IN0 + I_OUT + I_UP + I_DN + I_IN1 + I_OUT + I_UP + I_DN;
    for (int it = gw; it < NITEMS; it += NGW) {
        int r = it;
        if (r < I_IN0) { transpose_item(a.in[4], 1024, 3072, (bf16_t*)(ws + WS_WIN0), a.in[1], scr, r, lane); continue; } r -= I_IN0;
        if (r < I_OUT) { transpose_item(a.in[14], 1024, 1024, (bf16_t*)(ws + WS_WOUT0), nullptr, scr, r, lane); continue; } r -= I_OUT;
        if (r < I_UP) { transpose_item(a.in[22], 1024, 5632, (bf16_t*)(ws + WS_WUP0), a.in[2], scr, r, lane, true); continue; } r -= I_UP;
        if (r < I_DN) { transpose_item(a.in[25], 2816, 1024, (bf16_t*)(ws + WS_WDN0), nullptr, scr, r, lane); continue; } r -= I_DN;
        if (r < I_IN1) { transpose_item(a.in[15], 1024, 2048, (bf16_t*)(ws + WS_WIN1), a.in[1] + 1024, scr, r, lane); continue; } r -= I_IN1;
        if (r < I_OUT) { transpose_item(a.in[21], 1024, 1024, (bf16_t*)(ws + WS_WOUT1), nullptr, scr, r, lane); continue; } r -= I_OUT;
        if (r < I_UP) { transpose_item(a.in[22] + (size_t)1024 * 5632, 1024, 5632, (bf16_t*)(ws + WS_WUP1), a.in[2] + 1024, scr, r, lane, true); continue; } r -= I_UP;
        transpose_item(a.in[25] + (size_t)2816 * 1024, 2816, 1024, (bf16_t*)(ws + WS_WDN1), nullptr, scr, r, lane);
    }
    { const float* w_s = a.in[19]; bf16_t* wsc = (bf16_t*)(ws + WS_WSC);
      for (int i = bid_() * NTHR + tid; i < 8 * 128 * 128; i += (int)gridDim.x * NTHR) { const int t = (i >> 7) & 127, s = i & 127; wsc[i] = (s <= t) ? f2bf(w_s[i]) : (bf16_t)0; } }
    { const float* x = a.in[0]; bf16_t* xb = (bf16_t*)(ws + WS_HB); float* ssq = (float*)(ws + WS_SSQ);
      for (int m = gw; m < MTOK; m += NGW) {
          const f32x4* xr = (const f32x4*)(x + (size_t)m * DM) + lane; f32x4 v[4]; float s = 0.f;
#pragma unroll
          for (int j = 0; j < 4; ++j) { v[j] = xr[64 * j]; s += (v[j][0] * v[j][0] + v[j][1] * v[j][1]) + (v[j][2] * v[j][2] + v[j][3] * v[j][3]); }
          s = wave_sum(s);
          u32x2* o8 = (u32x2*)(xb + (size_t)m * DM) + lane;
#pragma unroll
          for (int j = 0; j < 4; ++j) { u32x2 w; w.x = cvt_pk_bf16(v[j][0], v[j][1]); w.y = cvt_pk_bf16(v[j][2], v[j][3]); o8[64 * j] = w; }
          if (lane < 16) ssq[(size_t)m * 16 + lane] = (lane == 0) ? s : 0.f;
      } }
}

template <bool FINAL>
DI void lru_item(LAS unsigned char* lds, const Args& a, int it) {
    const int tid = tid_(), lane = tid & 63, w = tid >> 6;
    const int b = it >> 5, cb = (it >> 2) & 7, seg = it & 3;
    const bf16_t* z = (const bf16_t*)(a.ws + WS_Z); bf16_t* mix = (bf16_t*)(a.ws + WS_MIX); float* agg = (float*)(a.ws + WS_LRUAGG);
    LAS bf16_t* WaT = (LAS bf16_t*)lds;
    LAS bf16_t* WxT = WaT + 64 * 72;
    LAS bf16_t* XR = WxT + 64 * 72;
    LAS bf16_t* XC = XR + 132 * 64;
    LAS float* AA = (LAS float*)(XC + 128 * 72);
    LAS float* UU = AA + 128 * 64;
    LAS float* SPp = UU + 128 * 64;
    LAS float* SHh = SPp + 512;
    LAS float* TAB = SHh + 512;
    LAS bf16_t* YT = (LAS bf16_t*)(TAB + 512);
    static_assert((64 * 72 * 2 + 132 * 64 + 128 * 72) * 2 + (128 * 64 * 2 + 512 * 3) * 4 + 128 * 64 * 2 <= 158720, "lru lds");
    { const float* wa = a.in[7] + cb * 4096; const float* wx = a.in[9] + cb * 4096;
#pragma unroll
      for (int r = 0; r < 8; ++r) { const int e = tid + 512 * r, i = e >> 6, j = e & 63; WaT[j * 72 + i] = f2bf(wa[e]); WxT[j * 72 + i] = f2bf(wx[e]); }
      if (tid < 64) { const int ch = cb * 64 + tid;
#pragma unroll
          for (int k = 0; k < 4; ++k) TAB[k * 64 + tid] = a.in[5][k * 512 + ch];
          TAB[256 + tid] = a.in[6][ch]; TAB[320 + tid] = a.in[8][ch]; TAB[384 + tid] = a.in[10][ch]; TAB[448 + tid] = log1pf(expf(-a.in[11][ch])); } }
    const int c = tid & 63, sub = tid >> 6;
    float h = 0.f, Ptot = 1.f;
    if (FINAL) for (int j = 0; j < seg; ++j) { const f32x2 pq = *(const f32x2*)(agg + ((size_t)((b * 4 + j) * 512 + cb * 64 + c)) * 2); h = pq[0] * h + pq[1]; }
    const bf16_t* zb = z + (size_t)b * TSEQ * 3072 + cb * 64 + (tid & 7) * 8;
    const int prow = tid >> 3;
    u32x4 pfx[3], pfy[2];
    { const int t0 = seg * 2048;
#pragma unroll
      for (int k = 0; k < 3; ++k) { const int r = prow + 64 * k, tok = t0 - 3 + r; u32x4 v = (u32x4){0u, 0u, 0u, 0u};
          if (r < 131 && tok >= 0) v = *(const u32x4*)(zb + (size_t)tok * 3072 + 512);
          if (r < 131) *(LAS u32x4*)(XR + r * 64 + (tid & 7) * 8) = v; }
      if (FINAL) {
#pragma unroll
          for (int k = 0; k < 2; ++k) pfy[k] = *(const u32x4*)(zb + (size_t)(t0 + prow + 64 * k) * 3072); } }
    __syncthreads();
    const float cw0 = TAB[c], cw1 = TAB[64 + c], cw2 = TAB[128 + c], cw3 = TAB[192 + c], cbv = TAB[256 + c];
    for (int tile = 0; tile < 16; ++tile) {
        const int t0 = seg * 2048 + tile * 128; const bool more = tile + 1 < 16;
        if (more) {
#pragma unroll
            for (int k = 0; k < 3; ++k) { const int r = prow + 64 * k; if (r < 131) pfx[k] = *(const u32x4*)(zb + (size_t)(t0 + 128 - 3 + r) * 3072 + 512); }
        }
        { float x0 = bf2f(XR[(sub * 16) * 64 + c]), x1 = bf2f(XR[(sub * 16 + 1) * 64 + c]), x2 = bf2f(XR[(sub * 16 + 2) * 64 + c]);
#pragma unroll
          for (int i = 0; i < 16; ++i) { const int t = sub * 16 + i; const float x3 = bf2f(XR[(t + 3) * 64 + c]);
              XC[t * 72 + c] = f2bf(cbv + cw0 * x0 + cw1 * x1 + cw2 * x2 + cw3 * x3); x0 = x1; x1 = x2; x2 = x3; } }
        __syncthreads();
        if (FINAL) {
#pragma unroll
            for (int k = 0; k < 2; ++k) *(LAS u32x4*)(YT + (prow + 64 * k) * 64 + (tid & 7) * 8) = pfy[k];
            if (more) {
#pragma unroll
                for (int k = 0; k < 2; ++k) pfy[k] = *(const u32x4*)(zb + (size_t)(t0 + 128 + prow + 64 * k) * 3072); }
        }
        {
            f32x4 accA[4], accX[4];
#pragma unroll
            for (int nt = 0; nt < 4; ++nt) { accA[nt] = (f32x4){0.f, 0.f, 0.f, 0.f}; accX[nt] = (f32x4){0.f, 0.f, 0.f, 0.f}; }
#pragma unroll
            for (int k = 0; k < 2; ++k) { const bf16x8 av = *(const LAS bf16x8*)(XC + (w * 16 + (lane & 15)) * 72 + k * 32 + 8 * (lane >> 4));
#pragma unroll
                for (int nt = 0; nt < 4; ++nt) { const bf16x8 ba = *(const LAS bf16x8*)(WaT + (nt * 16 + (lane & 15)) * 72 + k * 32 + 8 * (lane >> 4)), bx = *(const LAS bf16x8*)(WxT + (nt * 16 + (lane & 15)) * 72 + k * 32 + 8 * (lane >> 4));
                    accA[nt] = __builtin_amdgcn_mfma_f32_16x16x32_bf16(av, ba, accA[nt], 0, 0, 0); accX[nt] = __builtin_amdgcn_mfma_f32_16x16x32_bf16(av, bx, accX[nt], 0, 0, 0); } }
#pragma unroll
            for (int nt = 0; nt < 4; ++nt) { const int cc = nt * 16 + (lane & 15);
                const float ba = TAB[320 + cc], bx = TAB[384 + cc], spl = TAB[448 + cc];
#pragma unroll
                for (int j = 0; j < 4; ++j) { const int t = w * 16 + 4 * (lane >> 4) + j;
                    const float r = sigmoidf_(accA[nt][j] + ba), ig = sigmoidf_(accX[nt][j] + bx);
                    const float av = __expf(-8.0f * r * spl);
                    const float xc = bf2f(XC[t * 72 + cc]);
                    AA[t * 64 + cc] = av; UU[t * 64 + cc] = __builtin_amdgcn_sqrtf(1.0f - av * av) * (ig * xc); }
            }
        }
        __syncthreads();
        if (more) {
#pragma unroll
            for (int k = 0; k < 3; ++k) { const int r = prow + 64 * k; if (r < 131) *(LAS u32x4*)(XR + r * 64 + (tid & 7) * 8) = pfx[k]; }
        }
        { float P = 1.f, Hh = 0.f;
#pragma unroll
          for (int i = 0; i < 16; ++i) { const int t = sub * 16 + i; const float a_ = AA[t * 64 + c], u_ = UU[t * 64 + c]; Hh = a_ * Hh + u_; P *= a_; }
          SPp[sub * 64 + c] = P; SHh[sub * 64 + c] = Hh; }
        __syncthreads();
        float hin = h;
#pragma unroll
        for (int s = 0; s < 8; ++s) { const float p = SPp[s * 64 + c], q = SHh[s * 64 + c]; if (s < sub) hin = p * hin + q; h = p * h + q; Ptot *= p; }
        if (FINAL) {
            float hh = hin;
#pragma unroll
            for (int i = 0; i < 16; ++i) { const int t = sub * 16 + i;
                hh = AA[t * 64 + c] * hh + UU[t * 64 + c];
                const float y = bf2f(YT[t * 64 + c]);
                YT[t * 64 + c] = f2bf(y * hh); }
            __syncthreads();
#pragma unroll
            for (int k = 0; k < 2; ++k) { const int r = prow + 64 * k;
                *(u32x4*)(mix + ((size_t)b * TSEQ + t0 + r) * 1024 + cb * 64 + (tid & 7) * 8) = *(const LAS u32x4*)(YT + r * 64 + (tid & 7) * 8); }
        }
    }
    if (!FINAL && sub == 0) *(f32x2*)(agg + ((size_t)((b * 4 + seg) * 512 + cb * 64 + c)) * 2) = (f32x2){Ptot, h};
    __syncthreads();
}

template <bool FINAL>
DI void hgrn_item(LAS unsigned char* lds, const Args& a, int it) {
    const int tid = tid_(), lane = tid & 63, w = tid >> 6, l15 = lane & 15, q4 = lane >> 4;
    const int bh = it >> 3, seg = it & 7, b = bh >> 2, hd = bh & 3;
    const bf16_t* z = (const bf16_t*)(a.ws + WS_Z); bf16_t* mix = (bf16_t*)(a.ws + WS_MIX);
    float* HGS = (float*)(a.ws + WS_HGS); float* HGD = (float*)(a.ws + WS_HGD);
    LAS bf16_t* QS = (LAS bf16_t*)lds;
    LAS bf16_t* KS = QS + 64 * 136;
    LAS bf16_t* KSt = KS + 64 * 136;
    LAS bf16_t* Vt = KSt + 128 * 72;
    LAS bf16_t* Pm = Vt + 128 * 72;
    LAS bf16_t* St = Pm + 64 * 72;
    LAS float* CS = (LAS float*)(St + 128 * 136);
    LAS float* EM = CS + 512; LAS float* EL = EM + 128; LAS float* DEC = EL + 128; LAS float* GN = DEC + 128;
    LAS bf16_t* RV = (LAS bf16_t*)(GN + 128);
    LAS bf16_t* RF = Pm;
    LAS bf16_t* RQ = RF + 64 * 128;
    LAS float* OB = (LAS float*)lds;
    static_assert((64 * 136 * 2 + 128 * 72 * 2 + 64 * 72 + 128 * 136) * 2 + (512 + 128 * 4) * 4 + 64 * 128 * 2 <= 158720, "hgrn lds");
    static_assert(64 * 132 * 4 <= 64 * 136 * 2 * 2 && 2 * 64 * 128 <= 64 * 72 + 128 * 136, "hgrn aliases");
    const int dk = tid & 127, sub = tid >> 7;
    float lbv;
    { const float* lg = a.in[12]; const int col = hd * 128 + dk; const float l0 = lg[col], l1 = lg[512 + col], l2 = lg[1024 + col];
      const float mx = fmaxf(l0, fmaxf(l1, l2)); const float e0 = __expf(l0 - mx), e1 = __expf(l1 - mx), e2 = __expf(l2 - mx); lbv = e0 / (e0 + e1 + e2); }
    if (tid < 128) GN[tid] = a.in[13][tid];
    f32x4 Sacc[8];
#pragma unroll
    for (int nt = 0; nt < 8; ++nt) Sacc[nt] = (f32x4){0.f, 0.f, 0.f, 0.f};
    if (FINAL) for (int j = 0; j < seg; ++j) { const int itj = bh * 8 + j;
#pragma unroll
        for (int nt = 0; nt < 8; ++nt) { const float d = HGD[(size_t)itj * 128 + nt * 16 + l15];
            const f32x4 sj = *(const f32x4*)(HGS + (size_t)itj * 16384 + (size_t)((w * 8 + nt) * 64 + lane) * 4); Sacc[nt] = Sacc[nt] * d + sj; } }
    float dtot = 1.f;
    const size_t tok0 = (size_t)b * TSEQ + seg * 1024;
    const bf16_t* zbase = z + (tok0 + (tid >> 4)) * 3072 + hd * 128 + (tid & 15) * 8;
    const int roff = (tid >> 4) * 128 + (tid & 15) * 8;
    u32x4 pf_f[2], pf_v[2], pf_q[2];
#pragma unroll
    for (int k = 0; k < 2; ++k) { const bf16_t* p = zbase + (size_t)(32 * k) * 3072; pf_f[k] = *(const u32x4*)(p + 1536); pf_v[k] = *(const u32x4*)(p + 2048); if (FINAL) pf_q[k] = *(const u32x4*)(p + 1024); }
#pragma unroll
    for (int k = 0; k < 2; ++k) { *(LAS u32x4*)(RF + roff + k * 4096) = pf_f[k]; *(LAS u32x4*)(RV + roff + k * 4096) = pf_v[k]; if (FINAL) *(LAS u32x4*)(RQ + roff + k * 4096) = pf_q[k]; }
    __syncthreads();
    for (int ck = 0; ck < 16; ++ck) {
        const size_t rowbase = tok0 + ck * 64;
        const bool more = ck + 1 < 16;
        if (more && !FINAL) {
#pragma unroll
            for (int k = 0; k < 2; ++k) { const bf16_t* p = zbase + (size_t)((ck + 1) * 64 + 32 * k) * 3072; pf_f[k] = *(const u32x4*)(p + 1536); pf_v[k] = *(const u32x4*)(p + 2048); }
        }
        float pf[16], kf[16];
        { float run = 1.f;
#pragma unroll
          for (int i = 0; i < 16; ++i) { const float fl = bf2f(RF[(sub * 16 + i) * 128 + dk]);
              const float f = lbv + (1.0f - lbv) * sigmoidf_(fl); kf[i] = 1.0f - f; run *= f; pf[i] = run; }
          CS[sub * 128 + dk] = run; }
        __syncthreads();
        {
            const float c0 = CS[dk], c1 = CS[128 + dk], c2 = CS[256 + dk], c3 = CS[384 + dk];
            const float offs = (sub > 0 ? c0 : 1.f) * (sub > 1 ? c1 : 1.f) * (sub > 2 ? c2 : 1.f);
            const float pmid = c0 * c1, plast = pmid * c2 * c3; const float rpmid = __builtin_amdgcn_rcpf(pmid);
#pragma unroll
            for (int hq = 0; hq < 2; ++hq) { unsigned kw[4], vw[4];
#pragma unroll
                for (int i3 = 0; i3 < 4; ++i3) { const int i2 = hq * 4 + i3; const int s = sub * 16 + 2 * i2; const float P0 = offs * pf[2 * i2], P1 = offs * pf[2 * i2 + 1];
                    kw[i3] = cvt_pk_bf16(kf[2 * i2] * pmid * __builtin_amdgcn_rcpf(P0), kf[2 * i2 + 1] * pmid * __builtin_amdgcn_rcpf(P1));
                    vw[i3] = (unsigned)RV[s * 128 + dk] | ((unsigned)RV[(s + 1) * 128 + dk] << 16);
                    if (FINAL) { KS[s * 136 + dk] = (bf16_t)(kw[i3] & 0xffffu); KS[(s + 1) * 136 + dk] = (bf16_t)(kw[i3] >> 16);
                        const float q0 = bf2f(RQ[s * 128 + dk]), q1 = bf2f(RQ[(s + 1) * 128 + dk]);
                        QS[s * 136 + dk] = f2bf(q0 * (P0 * rpmid)); QS[(s + 1) * 136 + dk] = f2bf(q1 * (P1 * rpmid)); } }
                *(LAS u32x4*)(KSt + dk * 72 + sub * 16 + hq * 8) = (u32x4){kw[0], kw[1], kw[2], kw[3]};
                *(LAS u32x4*)(Vt + dk * 72 + sub * 16 + hq * 8) = (u32x4){vw[0], vw[1], vw[2], vw[3]}; }
            if (sub == 0) { EM[dk] = pmid; EL[dk] = c2 * c3; DEC[dk] = plast; }
            dtot *= plast;
        }
        __syncthreads();
        if (more && FINAL) {
#pragma unroll
            for (int k = 0; k < 2; ++k) { const bf16_t* p = zbase + (size_t)((ck + 1) * 64 + 32 * k) * 3072; pf_f[k] = *(const u32x4*)(p + 1536); pf_v[k] = *(const u32x4*)(p + 2048); pf_q[k] = *(const u32x4*)(p + 1024); }
        }
        f32x4 oacc[4];
        u32x4 gpre[2];
        if (FINAL) {
#pragma unroll
            for (int nt = 0; nt < 8; ++nt) { const float em = EM[nt * 16 + l15];
#pragma unroll
                for (int j = 0; j < 4; ++j) St[(16 * w + 4 * q4 + j) * 136 + nt * 16 + l15] = f2bf(Sacc[nt][j] * em); }
            { const int mt = w >> 1, n0 = (w & 1) * 2; f32x4 sc0 = (f32x4){0.f, 0.f, 0.f, 0.f}, sc1 = sc0;
#pragma unroll
              for (int k = 0; k < 4; ++k) { const bf16x8 av = *(const LAS bf16x8*)(QS + (mt * 16 + l15) * 136 + k * 32 + 8 * q4);
                  const bf16x8 b0 = *(const LAS bf16x8*)(KS + (n0 * 16 + l15) * 136 + k * 32 + 8 * q4), b1 = *(const LAS bf16x8*)(KS + ((n0 + 1) * 16 + l15) * 136 + k * 32 + 8 * q4);
                  sc0 = __builtin_amdgcn_mfma_f32_16x16x32_bf16(av, b0, sc0, 0, 0, 0); sc1 = __builtin_amdgcn_mfma_f32_16x16x32_bf16(av, b1, sc1, 0, 0, 0); }
#pragma unroll
              for (int j = 0; j < 4; ++j) { const int t = mt * 16 + 4 * q4 + j, s0 = n0 * 16 + l15, s1 = s0 + 16;
                  Pm[t * 72 + s0] = (s0 <= t) ? f2bf(sc0[j]) : (bf16_t)0; Pm[t * 72 + s1] = (s1 <= t) ? f2bf(sc1[j]) : (bf16_t)0; } }
            __syncthreads();
#pragma unroll
            for (int m4 = 0; m4 < 4; ++m4) oacc[m4] = (f32x4){0.f, 0.f, 0.f, 0.f};
#pragma unroll
            for (int k = 0; k < 2; ++k) { const bf16x8 bv = *(const LAS bf16x8*)(Vt + (16 * w + l15) * 72 + k * 32 + 8 * q4);
#pragma unroll
                for (int m4 = 0; m4 < 4; ++m4) { const bf16x8 av = *(const LAS bf16x8*)(Pm + (m4 * 16 + l15) * 72 + k * 32 + 8 * q4); oacc[m4] = __builtin_amdgcn_mfma_f32_16x16x32_bf16(av, bv, oacc[m4], 0, 0, 0); } }
#pragma unroll
            for (int k = 0; k < 4; ++k) { const bf16x8 bv = *(const LAS bf16x8*)(St + (16 * w + l15) * 136 + k * 32 + 8 * q4);
#pragma unroll
                for (int m4 = 0; m4 < 4; ++m4) { const bf16x8 av = *(const LAS bf16x8*)(QS + (m4 * 16 + l15) * 136 + k * 32 + 8 * q4); oacc[m4] = __builtin_amdgcn_mfma_f32_16x16x32_bf16(av, bv, oacc[m4], 0, 0, 0); } }
        } else if (more) {
#pragma unroll
            for (int k = 0; k < 2; ++k) { *(LAS u32x4*)(RF + roff + k * 4096) = pf_f[k]; *(LAS u32x4*)(RV + roff + k * 4096) = pf_v[k]; }
        }
        {
            f32x4 kv[8];
#pragma unroll
            for (int nt = 0; nt < 8; ++nt) kv[nt] = (f32x4){0.f, 0.f, 0.f, 0.f};
#pragma unroll
            for (int k = 0; k < 2; ++k) { const bf16x8 av = *(const LAS bf16x8*)(Vt + (16 * w + l15) * 72 + k * 32 + 8 * q4);
#pragma unroll
                for (int nt = 0; nt < 8; ++nt) { const bf16x8 bv = *(const LAS bf16x8*)(KSt + (nt * 16 + l15) * 72 + k * 32 + 8 * q4); kv[nt] = __builtin_amdgcn_mfma_f32_16x16x32_bf16(av, bv, kv[nt], 0, 0, 0); } }
#pragma unroll
            for (int nt = 0; nt < 8; ++nt) { const float dec = DEC[nt * 16 + l15], el = EL[nt * 16 + l15]; Sacc[nt] = Sacc[nt] * dec + kv[nt] * el; }
        }
        if (FINAL) {
            { const u32x4* gp0 = (const u32x4*)(z + (rowbase + (tid >> 3)) * 3072 + 2560 + hd * 128 + (tid & 7) * 16); gpre[0] = gp0[0]; gpre[1] = gp0[1]; }
            __syncthreads();
#pragma unroll
            for (int m4 = 0; m4 < 4; ++m4)
#pragma unroll
                for (int j = 0; j < 4; ++j) OB[(m4 * 16 + 4 * q4 + j) * 132 + 16 * w + l15] = oacc[m4][j];
            if (more) {
#pragma unroll
                for (int k = 0; k < 2; ++k) { *(LAS u32x4*)(RF + roff + k * 4096) = pf_f[k]; *(LAS u32x4*)(RV + roff + k * 4096) = pf_v[k]; *(LAS u32x4*)(RQ + roff + k * 4096) = pf_q[k]; }
            }
            __syncthreads();
            const int t = tid >> 3, part = tid & 7; const size_t row = rowbase + t;
            f32x4 o[4]; float ss = 0.f;
#pragma unroll
            for (int i = 0; i < 4; ++i) { o[i] = *(const LAS f32x4*)(OB + t * 132 + part * 16 + i * 4); ss += (o[i][0] * o[i][0] + o[i][1] * o[i][1]) + (o[i][2] * o[i][2] + o[i][3] * o[i][3]); }
            ss += __shfl_xor(ss, 1); ss += __shfl_xor(ss, 2); ss += __shfl_xor(ss, 4);
            const float rstd = rsqrtf(ss * (1.0f / 128.0f) + 1e-6f);
            u32x4* op = (u32x4*)(mix + row * 1024 + 512 + hd * 128 + part * 16);
#pragma unroll
            for (int hh = 0; hh < 2; ++hh) { const u32x4 gw = gpre[hh]; u32x4 ow;
#pragma unroll
                for (int e = 0; e < 4; ++e) { const unsigned gword = gw[e]; const int i0 = hh * 8 + e * 2;
                    const float v0 = o[i0 >> 2][i0 & 3] * rstd * GN[part * 16 + i0] * bflo(gword);
                    const float v1 = o[(i0 + 1) >> 2][(i0 + 1) & 3] * rstd * GN[part * 16 + i0 + 1] * bfhi(gword);
                    ow[e] = cvt_pk_bf16(v0, v1); }
                op[hh] = ow; }
        } else {
            __syncthreads();
        }
    }
    if (!FINAL) {
#pragma unroll
        for (int nt = 0; nt < 8; ++nt) *(f32x4*)(HGS + (size_t)it * 16384 + (size_t)((w * 8 + nt) * 64 + lane) * 4) = Sacc[nt];
        if (sub == 0) HGD[(size_t)it * 128 + dk] = dtot;
    }
    __syncthreads();
}

template <bool FINAL> DI void phase_mixer0(LAS unsigned char* lds, const Args& a) {
#ifndef NO_HG
    for (int it = bid_(); it < 256; it += (int)gridDim.x) hgrn_item<FINAL>(lds, a, it);
#endif
#ifndef NO_LRU
    for (int it = bid_(); it < 256; it += (int)gridDim.x) lru_item<FINAL>(lds, a, it);
#endif
}

DI void phase_sgu(LAS unsigned char* lds, const Args& a) {
    const int tid = tid_(), lane = tid & 63, w = tid >> 6, c8 = tid & 15;
    const bf16_t* uv = (const bf16_t*)(a.ws + WS_UV); bf16_t* sg = (bf16_t*)(a.ws + WS_SG); const bf16_t* wsc = (const bf16_t*)(a.ws + WS_WSC); const float* vst = (const float*)(a.ws + WS_VST);
    LAS bf16_t* WC = (LAS bf16_t*)lds;
    LAS bf16_t* VnT = WC + 128 * 136;
    LAS float* MU = (LAS float*)(VnT + 128 * 136); LAS float* RS = MU + 128;
    LAS float* OT = (LAS float*)(lds + 70656);
    const int G = (int)gridDim.x;
    int cur_g = -1; float lg[8], lb8[8];
#pragma unroll
    for (int e = 0; e < 8; ++e) { lg[e] = 0.f; lb8[e] = 0.f; }
    u32x4 raw[4]; float mu_r = 0.f, rs_r = 0.f;
    int it = bid_();
    if (it < 4096) { const size_t rb = (size_t)(it >> 3) * 128; const int g = it & 7;
#pragma unroll
        for (int i = 0; i < 4; ++i) raw[i] = *(const u32x4*)(uv + (rb + (tid >> 4) + 32 * i) * 2048 + 1024 + g * 128 + c8 * 8);
        if (tid < 128) { const size_t row = rb + tid; float s1 = 0.f, s2 = 0.f;
#pragma unroll
            for (int p = 0; p < 16; ++p) { const f32x2 q = *(const f32x2*)(vst + (row * 16 + p) * 2); s1 += q[0]; s2 += q[1]; }
            mu_r = s1 * (1.0f / 1024.0f); rs_r = rsqrtf(fmaxf(s2 * (1.0f / 1024.0f) - mu_r * mu_r, 0.f) + 1e-6f); } }
    for (; it < 4096; it += G) {
        const int g = it & 7; const size_t rowbase = (size_t)(it >> 3) * 128;
        if (g != cur_g) { cur_g = g;
#pragma unroll
            for (int r = 0; r < 4; ++r) { const int e = tid + 512 * r, t = e >> 4, ch = e & 15; *(LAS u32x4*)(WC + t * 136 + ch * 8) = *(const u32x4*)(wsc + g * 16384 + t * 128 + ch * 8); }
#pragma unroll
            for (int e = 0; e < 8; ++e) { lg[e] = a.in[17][g * 128 + c8 * 8 + e]; lb8[e] = a.in[18][g * 128 + c8 * 8 + e]; } }
        if (tid < 128) { MU[tid] = mu_r; RS[tid] = rs_r; }
        u32x4 cur[4];
#pragma unroll
        for (int i = 0; i < 4; ++i) cur[i] = raw[i];
        __syncthreads();
        { const int nit = it + G;
          if (nit < 4096) { const size_t rb = (size_t)(nit >> 3) * 128; const int gn = nit & 7;
#pragma unroll
              for (int i = 0; i < 4; ++i) raw[i] = *(const u32x4*)(uv + (rb + (tid >> 4) + 32 * i) * 2048 + 1024 + gn * 128 + c8 * 8);
              if (tid < 128) { const size_t row = rb + tid; float s1 = 0.f, s2 = 0.f;
#pragma unroll
                  for (int p = 0; p < 16; ++p) { const f32x2 q = *(const f32x2*)(vst + (row * 16 + p) * 2); s1 += q[0]; s2 += q[1]; }
                  mu_r = s1 * (1.0f / 1024.0f); rs_r = rsqrtf(fmaxf(s2 * (1.0f / 1024.0f) - mu_r * mu_r, 0.f) + 1e-6f); } } }
        u32x4 uq[4];
#pragma unroll
        for (int i = 0; i < 4; ++i) uq[i] = *(const u32x4*)(uv + (rowbase + 16 * w + (lane >> 4) + 4 * i) * 2048 + g * 128 + (lane & 15) * 8);
        float bias4[4];
#pragma unroll
        for (int i = 0; i < 4; ++i) bias4[i] = a.in[20][g * 128 + 16 * w + (lane >> 4) + 4 * i];
#pragma unroll
        for (int i = 0; i < 4; ++i) { const int s = (tid >> 4) + 32 * i; const u32x4 rw = cur[i];
            const float mu = MU[s], rs = RS[s];
#pragma unroll
            for (int e = 0; e < 4; ++e) { const float v0 = (bflo(rw[e]) - mu) * rs * lg[2 * e] + lb8[2 * e], v1 = (bfhi(rw[e]) - mu) * rs * lg[2 * e + 1] + lb8[2 * e + 1];
                const int ps = ((((s >> 3) ^ c8) & 15) << 3) + (s & 7);
                VnT[(c8 * 8 + 2 * e) * 136 + ps] = f2bf(v0); VnT[(c8 * 8 + 2 * e + 1) * 136 + ps] = f2bf(v1); } }
        __syncthreads();
        f32x4 acc[8];
#pragma unroll
        for (int nt = 0; nt < 8; ++nt) acc[nt] = (f32x4){0.f, 0.f, 0.f, 0.f};
#pragma unroll
        for (int k = 0; k < 4; ++k) { const bf16x8 av = *(const LAS bf16x8*)(WC + (16 * w + (lane & 15)) * 136 + k * 32 + 8 * (lane >> 4));
#pragma unroll
            for (int nt = 0; nt < 8; ++nt) { const int cr = nt * 16 + (lane & 15); const bf16x8 bv = *(const LAS bf16x8*)(VnT + cr * 136 + ((((k * 4 + (lane >> 4)) ^ (cr >> 3)) & 15) << 3));
                acc[nt] = __builtin_amdgcn_mfma_f32_16x16x32_bf16(av, bv, acc[nt], 0, 0, 0); } }
#pragma unroll
        for (int nt = 0; nt < 8; ++nt)
#pragma unroll
            for (int j = 0; j < 4; ++j) OT[(16 * w + 4 * (lane >> 4) + j) * 132 + nt * 16 + (lane & 15)] = acc[nt][j];
        asm volatile("s_waitcnt lgkmcnt(0)" ::: "memory");
#pragma unroll
        for (int i = 0; i < 4; ++i) { const int tl = 16 * w + (lane >> 4) + 4 * i; const float bias = bias4[i];
            const f32x4 o0 = *(const LAS f32x4*)(OT + tl * 132 + (lane & 15) * 8), o1 = *(const LAS f32x4*)(OT + tl * 132 + (lane & 15) * 8 + 4);
            const u32x4 uu = uq[i]; u32x4 ow;
            ow.x = cvt_pk_bf16(bflo(uu.x) * (o0[0] + bias), bfhi(uu.x) * (o0[1] + bias)); ow.y = cvt_pk_bf16(bflo(uu.y) * (o0[2] + bias), bfhi(uu.y) * (o0[3] + bias));
            ow.z = cvt_pk_bf16(bflo(uu.z) * (o1[0] + bias), bfhi(uu.z) * (o1[1] + bias)); ow.w = cvt_pk_bf16(bflo(uu.w) * (o1[2] + bias), bfhi(uu.w) * (o1[3] + bias));
            *(u32x4*)(sg + (rowbase + tl) * 1024 + g * 128 + (lane & 15) * 8) = ow; }
        __syncthreads();
    }
}

DI void phase_final(const Args& a) {
    const int tid = tid_(), lane = tid & 63, wave = tid >> 6;
    const int gw = bid_() * 8 + wave, NGW = (int)gridDim.x * 8;
    const float* ssq = (const float*)(a.ws + WS_SSQ); const float* gn = a.in[3]; const bf16_t* hb = (const bf16_t*)(a.ws + WS_HB);
    f32x4 gv[4];
#pragma unroll
    for (int j = 0; j < 4; ++j) gv[j] = *((const f32x4*)gn + lane + 64 * j);
    for (int m = gw; m < MTOK; m += NGW) {
        const float rs = ssq_rs(ssq, (size_t)m);
        const u32x2* hp = (const u32x2*)(hb + (size_t)m * DM) + lane; f32x4* p = (f32x4*)(a.out + (size_t)m * DM) + lane;
#pragma unroll
        for (int j = 0; j < 4; ++j) { const u32x2 r = hp[64 * j]; const f32x4 v = (f32x4){bflo(r.x), bfhi(r.x), bflo(r.y), bfhi(r.y)}; p[64 * j] = v * rs * gv[j]; }
    }
}

#define XB_TMO      128
#define XB_XCNT(j)  (256  + 64 * (j))
#define XB_XSUB(j)  (1280 + 64 * (j))
#define XB_XGEN(j)  (2304 + 64 * (j))
#define XB_TOP      3328
#define XB_TOPGEN   3392
#define XCD_BAR_WORDS 3456
#define XB_SPIN_CAP (1u << 22)
DI unsigned xb_ld(unsigned* p)              { return __hip_atomic_load(p, __ATOMIC_RELAXED, __HIP_MEMORY_SCOPE_AGENT); }
DI unsigned xb_add(unsigned* p, unsigned v) { return __hip_atomic_fetch_add(p, v, __ATOMIC_RELAXED, __HIP_MEMORY_SCOPE_AGENT); }
DI unsigned xb_xcc_id() { return (unsigned)__builtin_amdgcn_s_getreg((3 << 11) | 20) & 0xFu; }
#define XB_SPIN(cond, bar) do { unsigned _sp = 0; while (cond) { __builtin_amdgcn_s_sleep(1); \
    if ((++_sp & 255u) == 0u) { if (xb_ld(&(bar)[XB_TMO])) break; if (_sp > XB_SPIN_CAP) { atomicAdd(&(bar)[XB_TMO], 1u); break; } } } } while (0)
struct XcdBarrier { unsigned* bar; unsigned x; volatile LAS unsigned* st; };
DI XcdBarrier xcd_barrier_post(unsigned* bar, volatile LAS unsigned* st) {
    XcdBarrier b; b.bar = bar; b.x = xb_xcc_id(); b.st = st;
    if (threadIdx.x == 0) (void)xb_add(&bar[XB_XCNT(b.x)], 1u);
    return b;
}
DI void xcd_barrier_complete(unsigned* bar, unsigned x, unsigned& nloc, unsigned& nx) {
    const unsigned G = gridDim.x * gridDim.y * gridDim.z;
    unsigned sum, cnt, mine, sp = 0u;
    for (;;) {
        sum = 0u; cnt = 0u; mine = 0u;
#pragma unroll
        for (unsigned j = 0; j < 16; ++j) { const unsigned c = xb_ld(&bar[XB_XCNT(j)]); sum += c; cnt += (c > 0u) ? 1u : 0u; mine = (j == x) ? c : mine; }
        if (sum == G) break;
        __builtin_amdgcn_s_sleep(1);
        if ((++sp & 255u) == 0u) { if (xb_ld(&bar[XB_TMO])) break; if (sp > XB_SPIN_CAP) { atomicAdd(&bar[XB_TMO], 1u); break; } }
    }
    nloc = mine > 0u ? mine : 1u; nx = cnt > 0u ? cnt : 1u;
}
DI void xcd_barrier(const XcdBarrier& b) {
    asm volatile("s_waitcnt vmcnt(0)" ::: "memory");
    __syncthreads();
    if (threadIdx.x == 0) {
        unsigned* bar = b.bar;
        __builtin_amdgcn_s_waitcnt(0);
        unsigned nloc = b.st[0], nx = b.st[1];
        if (nloc == 0u) { xcd_barrier_complete(bar, b.x, nloc, nx); b.st[0] = nloc; b.st[1] = nx; }
        const unsigned old = xb_add(&bar[XB_XSUB(b.x)], 1u);
        const unsigned gen = old / nloc;
        if (old + 1u == (gen + 1u) * nloc) {
            __builtin_amdgcn_fence(__ATOMIC_RELEASE, "agent");
            asm volatile("s_waitcnt vmcnt(0)" ::: "memory");
            const unsigned og = xb_add(&bar[XB_TOP], 1u);
            const unsigned tg = og / nx;
            if (og + 1u == (tg + 1u) * nx) xb_add(&bar[XB_TOPGEN], 1u);
            else XB_SPIN(xb_ld(&bar[XB_TOPGEN]) == tg, bar);
            __builtin_amdgcn_fence(__ATOMIC_ACQUIRE, "agent");
            xb_add(&bar[XB_XGEN(b.x)], 1u);
            asm volatile("s_waitcnt vmcnt(0)" ::: "memory");
        } else {
            XB_SPIN(xb_ld(&bar[XB_XGEN(b.x)]) == gen, bar);
            __builtin_amdgcn_fence(__ATOMIC_ACQUIRE, "agent");
            asm volatile("s_waitcnt vmcnt(0)" ::: "memory");
        }
    }
    __syncthreads();
}

constexpr int NPHASE = 13;
#ifndef REP_MASK
#define REP_MASK 0
#endif
#ifndef USE_CG_SYNC
#define USE_CG_SYNC 0
#endif
#ifndef PH_MASK
#define PH_MASK 0xFFFF
#endif
#define PHM(k) (((PH_MASK) >> (k)) & 1)
__global__ void __launch_bounds__(NTHR, 2) mk_fwd(Args a) {
    extern __shared__ __attribute__((aligned(16))) unsigned char lds_raw[];
    LAS unsigned char* lds = (LAS unsigned char*)lds_raw;
    unsigned char* ws = a.ws;
    bf16_t* hb = (bf16_t*)(ws + WS_HB); float* ssq = (float*)(ws + WS_SSQ); float* H = a.out;
    volatile LAS unsigned* bst = (volatile LAS unsigned*)(lds + 131072 + 4096 + 23552);
    if (threadIdx.x < 4) bst[threadIdx.x] = 0u;
    __syncthreads();
    XcdBarrier xb = xcd_barrier_post((unsigned*)ws, bst);
    if (threadIdx.x == 0) { const unsigned xcc = xb.x & 7u; bst[2] = xcc; bst[3] = xb_add((unsigned*)ws + 4096 + 64 * xcc, 1u); }
    int vc = (int)blockIdx.x; bool vc_done = false;
    for (int pi = a.ph_lo; pi < a.ph_hi; ++pi) {
        const int ph = a.seq[pi];
        if (pi > 0 && !vc_done) {
            if (threadIdx.x == 0) { bool ok = (gridDim.x % 8u) == 0u;
                for (unsigned j = 0; j < 8; ++j) ok = ok && (xb_ld((unsigned*)ws + 4096 + 64 * j) == gridDim.x / 8u);
                bst[2] = ok ? (bst[2] + 8u * bst[3]) : blockIdx.x; }
            __syncthreads(); vc = __builtin_amdgcn_readfirstlane((int)bst[2]); vc_done = true;
        }
        if (PHM(0) && ph == 0) phase_prep(lds, a);
        else if (PHM(1) && ph == 1) { EpiScale E{(bf16_t*)(ws + WS_Z), 3072, (const LAS float*)(lds + RST_OFF)}; run_gemm<EpiScale, true>(lds, vc, hb, (const bf16_t*)(ws + WS_WIN0), MTOK, 3072, 1024, E, ssq); }
        else if (PHM(2) && ph == 2) phase_mixer0<false>(lds, a);
        else if (PHM(3) && ph == 3) phase_mixer0<true>(lds, a);
        else if (PHM(4) && (ph == 4 || ph == 9)) {
            EpiRes E{hb, ssq};
            run_gemm(lds, vc, (const bf16_t*)(ws + (ph == 4 ? WS_MIX : WS_SG)), (const bf16_t*)(ws + (ph == 4 ? WS_WOUT0 : WS_WOUT1)), MTOK, 1024, 1024, E);
        }
        else if (PHM(5) && ph == 7) { EpiGelu E{(bf16_t*)(ws + WS_UV), 2048, (const LAS float*)(lds + RST_OFF), a.in[16], (float*)(ws + WS_VST)}; run_gemm(lds, vc, hb, (const bf16_t*)(ws + WS_WIN1), MTOK, 2048, 1024, E, ssq); }
        else if (PHM(6) && ph == 8) phase_sgu(lds, a);
        else if (PHM(7) && ph == 12) phase_final(a);
        else if (PHM(8) && (ph == 5 || ph == 10)) {
            const int layer = (ph == 10);
            EpiFfn E{(bf16_t*)(ws + WS_ACT), (const LAS float*)(lds + RST_OFF), a.in[23] + (size_t)layer * 3 * DFF, a.in[24] + (size_t)layer * DFF, (LAS float*)(lds + 131072)};
            run_gemm_ffn(lds, vc, hb, (const bf16_t*)(ws + (layer ? WS_WUP1 : WS_WUP0)), ssq, E);
        }
        else if (PHM(9) && (ph == 6 || ph == 11)) {
            const int layer = (ph == 11);
            EpiRes E{hb, ssq}; run_gemm(lds, vc, (const bf16_t*)(ws + WS_ACT), (const bf16_t*)(ws + (layer ? WS_WDN1 : WS_WDN0)), MTOK, 1024, DFF, E);
        }
        if (pi + 1 < a.ph_hi) {
            if (USE_CG_SYNC || a.ph_hi > 1000) { __threadfence(); cg::this_grid().sync(); }
            else xcd_barrier(xb);
        }
    }
}

extern "C" void kernel_launch(void* const* d_in, const int* in_sizes, int n_in, void* d_out, int out_size, void* d_ws, size_t ws_size, hipStream_t stream) {
    static int grid = 0;
    if (grid == 0) {
        if (n_in != 26 || ws_size < WS_END) { fprintf(stderr, "kernel_launch: unexpected n_in %d / ws_size %zu (need %zu)\n", n_in, ws_size, (size_t)WS_END); grid = -1; return; }
        int dev = 0, cus = 0, per_cu = 0;
        (void)hipGetDevice(&dev); (void)hipDeviceGetAttribute(&cus, hipDeviceAttributeMultiprocessorCount, dev);
        if (hipFuncSetAttribute((const void*)mk_fwd, hipFuncAttributeMaxDynamicSharedMemorySize, LDS_BYTES) != hipSuccess) { fprintf(stderr, "kernel_launch: hipFuncSetAttribute failed\n"); grid = -1; return; }
        if (hipOccupancyMaxActiveBlocksPerMultiprocessor(&per_cu, (const void*)mk_fwd, NTHR, LDS_BYTES) != hipSuccess || per_cu < 1) { fprintf(stderr, "kernel_launch: occupancy query gave %d\n", per_cu); per_cu = 1; }
        (void)hipGetLastError();
        grid = cus * per_cu;
    }
    if (grid < 0) return;
    Args a{};
    for (int i = 0; i < 26; ++i) a.in[i] = (const float*)d_in[i];
    a.out = (float*)d_out; a.ws = (unsigned char*)d_ws;
#if ONE_LAUNCH
    { int n = 0; for (int ph = 0; ph < NPHASE; ++ph) { a.seq[n++] = ph; if ((REP_MASK >> ph) & 1) a.seq[n++] = ph; } a.ph_lo = 0; a.ph_hi = n; }
    if (hipMemsetAsync(d_ws, 0, 32768, stream) != hipSuccess) { fprintf(stderr, "kernel_launch: memset of the barrier words failed\n"); return; }
    void* args[] = {&a};
    hipError_t e = hipLaunchCooperativeKernel((const void*)mk_fwd, dim3(grid), dim3(NTHR), args, LDS_BYTES, stream);
    if (e != hipSuccess) fprintf(stderr, "cooperative launch failed: %s (grid %d)\n", hipGetErrorString(e), grid);
#else
    for (int ph = 0; ph < NPHASE; ++ph) {
        a.seq[0] = ph; a.ph_lo = 0; a.ph_hi = 1;
        hipLaunchKernelGGL(mk_fwd, dim3(grid), dim3(NTHR), LDS_BYTES, stream, a);
    }
#endif
}
```
